# Optimizing an MI355X kernel written in HIP

```python
import jax, jax.numpy as jnp
from jax import lax
import numpy as np

D_MODEL = 1024
BATCH = 2
SEQ = 8192
DEPTH = 1

HEAD_DIM = 64
MOBA_HEADS = 8
SB_HEADS = 8
MOBA_WIDTH = MOBA_HEADS * HEAD_DIM
SB_WIDTH = SB_HEADS * HEAD_DIM
MOBA_BLOCK = 256
MOBA_TOPK = 3
MOBA_QCHUNK = 64
SB_QBLOCK = 128
ROPE_THETA = 10000.0
D_FF = 2816
CONV_WIDTH = 3
N_BRANCHES = 2
RMS_EPS = 1e-6
NEG = -1e30
IN_SIZES = (MOBA_WIDTH, MOBA_WIDTH, MOBA_WIDTH, SB_WIDTH, SB_WIDTH, SB_WIDTH, N_BRANCHES * D_MODEL)
IN_COLS = sum(IN_SIZES)
IN_SPLITS = tuple(int(s) for s in np.cumsum(IN_SIZES)[:-1])

kernel_name = "hybrid_moba_stickbreaking_convglu"


def rms_norm(x, g):
    xf = x.astype(jnp.float32)
    y = xf * lax.rsqrt(jnp.mean(xf * xf, axis=-1, keepdims=True) + RMS_EPS)
    return (y * g.astype(jnp.float32)).astype(x.dtype)


def to_heads(t, n_heads):
    b, s, _ = t.shape
    return t.reshape(b, s, n_heads, HEAD_DIM).transpose(0, 2, 1, 3)


def from_heads(t):
    b, h, s, d = t.shape
    return t.transpose(0, 2, 1, 3).reshape(b, s, h * d)


def rope(t, pos):
    half = HEAD_DIM // 2
    inv = ROPE_THETA ** (-jnp.arange(half, dtype=jnp.float32) / half)
    ang = pos[:, None] * inv[None, :]
    cos, sin = jnp.cos(ang), jnp.sin(ang)
    tf = t.astype(jnp.float32)
    t1, t2 = tf[..., :half], tf[..., half:]
    out = jnp.concatenate([t1 * cos - t2 * sin, t2 * cos + t1 * sin], axis=-1)
    return out.astype(t.dtype)


def moba_attention(q, k, v):
    b, h, s, d = q.shape
    nb = -(-s // MOBA_BLOCK)
    pad = nb * MOBA_BLOCK - s
    kp = jnp.pad(k, ((0, 0), (0, 0), (0, pad), (0, 0)))
    vp = jnp.pad(v, ((0, 0), (0, 0), (0, pad), (0, 0)))
    k_blk = kp.reshape(b, h, nb, MOBA_BLOCK, d)
    v_blk = vp.reshape(b, h, nb, MOBA_BLOCK, d)
    k_mean = jnp.mean(k_blk.astype(jnp.float32), axis=3)
    gate = jnp.einsum('bhtd,bhnd->bhtn', q.astype(jnp.float32), k_mean)
    q_block = jnp.arange(s) // MOBA_BLOCK
    past = jnp.arange(nb)[None, :] < q_block[:, None]
    gate = jnp.where(past, gate, NEG)
    n_sel = min(MOBA_TOPK, nb)
    _, idx = lax.top_k(gate, n_sel)

    nc = s // MOBA_QCHUNK
    q_c = q.reshape(b, h, nc, MOBA_QCHUNK, d).transpose(2, 0, 1, 3, 4)
    idx_c = idx.reshape(b, h, nc, MOBA_QCHUNK, n_sel).transpose(2, 0, 1, 3, 4)
    scale = HEAD_DIM ** -0.5
    gather = jax.vmap(jax.vmap(lambda blocks, ids: blocks[ids]))

    def chunk(args):
        c, qc, ic = args
        blk = (c * MOBA_QCHUNK) // MOBA_BLOCK
        t = c * MOBA_QCHUNK + jnp.arange(MOBA_QCHUNK)
        k_own = lax.dynamic_index_in_dim(k_blk, blk, axis=2, keepdims=False)
        v_own = lax.dynamic_index_in_dim(v_blk, blk, axis=2, keepdims=False)
        s_own = jnp.einsum('bhqd,bhkd->bhqk', qc, k_own, preferred_element_type=jnp.float32) * scale
        kpos = blk * MOBA_BLOCK + jnp.arange(MOBA_BLOCK)
        s_own = jnp.where(kpos[None, :] <= t[:, None], s_own, NEG)
        k_sel = gather(k_blk, ic)
        v_sel = gather(v_blk, ic)
        s_sel = jnp.einsum('bhqd,bhqnkd->bhqnk', qc, k_sel, preferred_element_type=jnp.float32) * scale
        valid = jnp.arange(n_sel) < blk
        s_sel = jnp.where(valid[:, None], s_sel, NEG)
        logits = jnp.concatenate([s_own, s_sel.reshape(b, h, MOBA_QCHUNK, n_sel * MOBA_BLOCK)], axis=-1)
        p = jax.nn.softmax(logits, axis=-1)
        p_own = p[..., :MOBA_BLOCK].astype(v.dtype)
        p_sel = p[..., MOBA_BLOCK:].reshape(b, h, MOBA_QCHUNK, n_sel, MOBA_BLOCK).astype(v.dtype)
        return (jnp.einsum('bhqk,bhkd->bhqd', p_own, v_own)
                + jnp.einsum('bhqnk,bhqnkd->bhqd', p_sel, v_sel))

    out = lax.map(chunk, (jnp.arange(nc), q_c, idx_c))
    return out.transpose(1, 2, 0, 3, 4).reshape(b, h, s, d)


def stick_breaking_attention(q, k, v):
    b, h, s, d = q.shape
    nc = s // SB_QBLOCK
    q_c = q.reshape(b, h, nc, SB_QBLOCK, d).transpose(2, 0, 1, 3, 4)
    spos = jnp.arange(s)
    scale = HEAD_DIM ** -0.5

    def block(args):
        c, qc = args
        t = c * SB_QBLOCK + jnp.arange(SB_QBLOCK)
        z = jnp.einsum('bhqd,bhkd->bhqk', qc, k, preferred_element_type=jnp.float32) * scale
        causal = spos[None, :] < t[:, None]
        log_1m = jnp.where(causal, -jax.nn.softplus(z), 0.0)
        after = lax.cumsum(log_1m, axis=3, reverse=True) - log_1m
        a = jnp.where(causal, jnp.exp(jax.nn.log_sigmoid(z) + after), 0.0)
        return jnp.einsum('bhqk,bhkd->bhqd', a.astype(v.dtype), v)

    out = lax.map(block, (jnp.arange(nc), q_c))
    return out.transpose(1, 2, 0, 3, 4).reshape(b, h, s, d)


def causal_depthwise_conv(u, w, bias):
    s = u.shape[1]
    up = jnp.pad(u, ((0, 0), (CONV_WIDTH - 1, 0), (0, 0)))
    out = up[:, 0:s] * w[0]
    for i in range(1, CONV_WIDTH):
        out = out + up[:, i:i + s] * w[i]
    return out + bias


def setup_inputs(seed: int = 0) -> dict:
    key = jax.random.key(seed)
    ks = jax.random.split(key, 14)
    f32 = jnp.float32
    nrm = lambda k, shape, fan: jax.random.normal(k, shape, f32) * (fan ** -0.5)
    return {
        "x": jax.random.normal(ks[0], (BATCH, SEQ, D_MODEL), f32),
        "g_mix": 1.0 + 0.01 * jax.random.normal(ks[1], (DEPTH, D_MODEL), f32),
        "w_in": nrm(ks[2], (DEPTH, D_MODEL, IN_COLS), D_MODEL),
        "b_gate": 0.01 * jax.random.normal(ks[3], (DEPTH, N_BRANCHES * D_MODEL), f32),
        "w_branch_a": nrm(ks[4], (DEPTH, MOBA_WIDTH, D_MODEL), MOBA_WIDTH),
        "w_branch_b": nrm(ks[5], (DEPTH, SB_WIDTH, D_MODEL), SB_WIDTH),
        "w_out": nrm(ks[6], (DEPTH, D_MODEL, D_MODEL), D_MODEL),
        "g_ffn": 1.0 + 0.01 * jax.random.normal(ks[7], (DEPTH, D_MODEL), f32),
        "w_up": nrm(ks[8], (DEPTH, D_MODEL, 2 * D_FF), D_MODEL),
        "conv_w": nrm(ks[9], (DEPTH, CONV_WIDTH, 2 * D_FF), CONV_WIDTH),
        "conv_b": 0.01 * jax.random.normal(ks[10], (DEPTH, 2 * D_FF), f32),
        "w_down": nrm(ks[11], (DEPTH, D_FF, D_MODEL), D_FF),
        "g_final": 1.0 + 0.01 * jax.random.normal(ks[12], (D_MODEL,), f32),
    }


def reference(x, g_mix, w_in, b_gate, w_branch_a, w_branch_b, w_out, g_ffn, w_up, conv_w, conv_b, w_down, g_final):
    b, s, _ = x.shape
    pos = jnp.arange(s, dtype=jnp.float32)
    for layer in range(DEPTH):
        h = rms_norm(x, g_mix[layer])
        proj = h @ w_in[layer]
        qa, ka, va, qb, kb, vb, gates = jnp.split(proj, IN_SPLITS, axis=-1)
        qa = rope(to_heads(qa, MOBA_HEADS), pos)
        ka = rope(to_heads(ka, MOBA_HEADS), pos)
        ya = from_heads(moba_attention(qa, ka, to_heads(va, MOBA_HEADS)))
        yb = from_heads(stick_breaking_attention(to_heads(qb, SB_HEADS), to_heads(kb, SB_HEADS),
                                                 to_heads(vb, SB_HEADS)))
        g = jax.nn.sigmoid(gates + b_gate[layer]).reshape(b, s, N_BRANCHES, D_MODEL)
        merged = g[:, :, 0] * (ya @ w_branch_a[layer]) + g[:, :, 1] * (yb @ w_branch_b[layer])
        x = x + merged @ w_out[layer]
        h = rms_norm(x, g_ffn[layer])
        u = causal_depthwise_conv(h @ w_up[layer], conv_w[layer], conv_b[layer])
        u_gate, u_val = jnp.split(u, 2, axis=-1)
        x = x + (jax.nn.silu(u_gate) * u_val) @ w_down[layer]
    return rms_norm(x, g_final)
```

```cpp
#include <hip/hip_runtime.h>
#include <hip/hip_cooperative_groups.h>
#include <cstdio>
#include <cstdint>
namespace cg = cooperative_groups;
namespace pg8 {
#define PG8_LAS __attribute__((address_space(3)))
typedef unsigned short bf16_t;
typedef short bf16x8 __attribute__((ext_vector_type(8)));
typedef float f32x4 __attribute__((ext_vector_type(4)));
typedef unsigned u32x4 __attribute__((ext_vector_type(4)));
constexpr int BM = 256, BK = 64, HALF = 128, HTB = HALF * BK * 2  , STAGE_BYTES = 8 * HTB, NXCD = 8, WGM = 8;

__host__ __device__ __forceinline__ int lds_byte(int r, int c) { const int st = (r >> 4) * 2 + (c >> 5), rr = r & 15, cc = c & 31, ob = rr * 64 + cc * 2; return st * 1024 + (ob ^ (((ob >> 9) & 1) << 5)); }
__host__ __device__ __forceinline__ void stage_rc(int b, int& R, int& C) { const int st = b / 1024, sb = b % 1024, swz = sb ^ (((sb >> 9) & 1) << 5); R = (st >> 1) * 16 + swz / 64; C = (st & 1) * 32 + (swz % 64) / 2; }
__host__ __device__ __forceinline__ int perm32(int rho) { const int n = rho >> 4, i = rho & 15; return 8 * (i >> 2) + 4 * n + (i & 3); }

struct Unit { int pm, pn; };
struct Gemm { const bf16_t* A; const bf16_t* Bt; int M, N, K; };

struct StaticOrder {
    int nM, nN, nwg, G, c;
    __host__ __device__ void init(int M, int N, int G_, int c_) { nM = M / BM; nN = N / BM; nwg = nM * nN; G = G_; c = c_; }
    __host__ __device__ bool next(int i, Unit& u) const {
        const long L = (long)i * G + c; if (L >= nwg) return false;
        int wgid = (int)L; { const int q = nwg / NXCD, r = nwg % NXCD, xcd = wgid % NXCD, off = wgid / NXCD; wgid = (xcd < r ? xcd * (q + 1) : r * (q + 1) + (xcd - r) * q) + off; }
        const int nig = WGM * nN, gid = wgid / nig, fm = gid * WGM, gsz = (nM - fm) < WGM ? (nM - fm) : WGM;
        u.pm = fm + ((wgid % nig) % gsz); u.pn = (wgid % nig) / gsz; return true;
    }
    __device__ __forceinline__ void a_ready(const Unit&) const {}
    __device__ __forceinline__ void done(const Unit&) const {}
};

__device__ __forceinline__ unsigned cvt_pk_bf16(float lo, float hi) { unsigned r; asm volatile("v_cvt_pk_bf16_f32 %0, %1, %2" : "=v"(r) : "v"(lo), "v"(hi)); return r; }
typedef float f32x2 __attribute__((ext_vector_type(2)));
template <class Epi, class Sched, bool ALIGN_EPI = false, bool SP2 = false>
__device__ __forceinline__ void gemm_phase(PG8_LAS unsigned char* lds, const Gemm g, const Sched& S, const Epi& E) {
    const int tid = threadIdx.x, wid = __builtin_amdgcn_readfirstlane(tid >> 6), lane = tid & 63, wr = wid >> 2, wc = wid & 3, fr = lane & 15, fq = lane >> 4;
    const int K = g.K, nt = K / BK;
    unsigned voffA[2], voffB[2];
#pragma unroll
    for (int i = 0; i < 2; ++i) { int R, C; stage_rc(tid * 16 + i * 8192, R, C); const int Rb = Epi::PERM ? ((R & ~31) + perm32(R & 31)) : R;
        voffA[i] = (unsigned)(R * K + C) * 2u; voffB[i] = (unsigned)(Rb * K + C) * 2u; }
    const size_t kstep = (size_t)(BK * 2);
    const size_t hstep = (size_t)HALF * K * 2;
    const size_t tstep = 2 * hstep;
    const unsigned ldsw = (unsigned)wid * 1024u;
    const int aoff = lds_byte(wr * 64 + fr, fq * 8), boff = lds_byte(wc * 32 + fr, fq * 8);
#define PG8_SA(b, h) (((b) * 2 + (h)) * HTB)
#define PG8_SB(b, h) ((4 + (b) * 2 + (h)) * HTB)
#define PG8_STAGE(bufoff, gbase, voff) do { _Pragma("unroll") for (int _i = 0; _i < 2; ++_i) \
        __builtin_amdgcn_global_load_lds((const unsigned*)((const char*)(gbase) + (voff)[_i]), (PG8_LAS unsigned*)(lds + (bufoff) + ldsw + _i * 8192), 16, 0, 0); } while (0)
#define PG8_LDA(dst, b, h) do { _Pragma("unroll") for (int m = 0; m < 4; ++m) _Pragma("unroll") for (int k = 0; k < 2; ++k) dst[m][k] = *(const PG8_LAS bf16x8*)(lds + PG8_SA(b, h) + aoff + m * 2048 + k * 1024); } while (0)
#define PG8_LDB(dst, b, h) do { _Pragma("unroll") for (int n = 0; n < 2; ++n) _Pragma("unroll") for (int k = 0; k < 2; ++k) dst[n][k] = *(const PG8_LAS bf16x8*)(lds + PG8_SB(b, h) + boff + n * 2048 + k * 1024); } while (0)
#define PG8_MMA(ai, bj, At, Bt) do { __builtin_amdgcn_s_setprio(1); _Pragma("unroll") for (int m = 0; m < 4; ++m) _Pragma("unroll") for (int n = 0; n < 2; ++n) _Pragma("unroll") for (int k = 0; k < 2; ++k) \
        acc[ai][bj][m][n] = __builtin_amdgcn_mfma_f32_16x16x32_bf16(Bt[n][k], At[m][k], acc[ai][bj][m][n], 0, 0, 0); __builtin_amdgcn_s_setprio(0); } while (0)
#define PG8_WAIT_V(n) asm volatile("s_waitcnt vmcnt(" #n ")" ::: "memory")
#define PG8_WAIT_L(n) asm volatile("s_waitcnt lgkmcnt(" #n ")" ::: "memory")
#define PG8_BAR __builtin_amdgcn_s_barrier()
#define PG8_SCHED __builtin_amdgcn_sched_barrier(0)
    Unit cur, nxt; int ui = 0;
    if (!S.next(0, cur)) return;
    f32x4 acc[2][2][4][2];
#pragma unroll
    for (int a = 0; a < 2; ++a)
#pragma unroll
        for (int b = 0; b < 2; ++b)
#pragma unroll
            for (int m = 0; m < 4; ++m)
#pragma unroll
                for (int n = 0; n < 2; ++n) acc[a][b][m][n] = (f32x4){0.f, 0.f, 0.f, 0.f};
    bf16x8 At[4][2], B0[2][2], B1[2][2];
    const char* cA = (const char*)g.A + (size_t)cur.pm * tstep; const char* cB = (const char*)g.Bt + (size_t)cur.pn * tstep;
    S.a_ready(cur);
    if constexpr (SP2) {
        PG8_STAGE(PG8_SB(0, 0), cB, voffB); PG8_STAGE(PG8_SB(0, 1), cB + hstep, voffB); PG8_STAGE(PG8_SA(0, 0), cA, voffA); PG8_STAGE(PG8_SA(0, 1), cA + hstep, voffA);
        if (wr == 1) PG8_BAR;
        PG8_WAIT_V(2); PG8_BAR;
        PG8_STAGE(PG8_SB(1, 0), cB + kstep, voffB); PG8_STAGE(PG8_SA(1, 0), cA + kstep, voffA); PG8_STAGE(PG8_SB(1, 1), cB + hstep + kstep, voffB);
        PG8_WAIT_V(6); PG8_BAR;
    } else {
        PG8_STAGE(PG8_SB(0, 0), cB, voffB); PG8_STAGE(PG8_SA(0, 0), cA, voffA); PG8_STAGE(PG8_SB(0, 1), cB + hstep, voffB); PG8_STAGE(PG8_SA(0, 1), cA + hstep, voffA);
        if (wr == 1) PG8_BAR;
        PG8_WAIT_V(4); PG8_BAR;
        PG8_STAGE(PG8_SB(1, 0), cB + kstep, voffB); PG8_STAGE(PG8_SA(1, 0), cA + kstep, voffA); PG8_STAGE(PG8_SB(1, 1), cB + hstep + kstep, voffB);
        PG8_WAIT_V(6); PG8_BAR;
    }
    for (;;) {
        const bool has_next = S.next(ui + 1, nxt);
        const char* nA = has_next ? (const char*)g.A + (size_t)nxt.pm * tstep : cA; const char* nB = has_next ? (const char*)g.Bt + (size_t)nxt.pn * tstep : cB;
        for (int t = 0; t < nt; t += 2) {
            const bool last = (t == nt - 2);
            const char* a1 = cA + (size_t)(t + 1) * kstep;
            const char* a2 = last ? nA : cA + (size_t)(t + 2) * kstep; const char* b2 = last ? nB : cB + (size_t)(t + 2) * kstep;
            const char* a3 = a2 + kstep; const char* b3 = b2 + kstep;
            if (last && has_next) S.a_ready(nxt);
            if constexpr (SP2) {
            PG8_LDB(B0, 0, 0); PG8_LDB(B1, 0, 1); PG8_SCHED; PG8_LDA(At, 0, 0); PG8_STAGE(PG8_SA(1, 1), a1 + hstep, voffA);
            PG8_WAIT_V(8); PG8_WAIT_L(0); PG8_BAR; PG8_MMA(0, 0, At, B0); PG8_MMA(0, 1, At, B1); PG8_BAR; PG8_SCHED;
            PG8_LDA(At, 0, 1); PG8_STAGE(PG8_SB(0, 0), b2, voffB); PG8_STAGE(PG8_SB(0, 1), b2 + hstep, voffB); PG8_STAGE(PG8_SA(0, 0), a2, voffA);
            PG8_WAIT_V(8); PG8_WAIT_L(0); PG8_BAR; PG8_MMA(1, 0, At, B0); PG8_MMA(1, 1, At, B1); PG8_BAR; PG8_SCHED;
            PG8_LDB(B0, 1, 0); PG8_LDB(B1, 1, 1); PG8_SCHED; PG8_LDA(At, 1, 0); PG8_STAGE(PG8_SA(0, 1), a2 + hstep, voffA);
            PG8_WAIT_V(8); PG8_WAIT_L(0); PG8_BAR; PG8_MMA(0, 0, At, B0); PG8_MMA(0, 1, At, B1); PG8_BAR; PG8_SCHED;
            PG8_LDA(At, 1, 1); PG8_STAGE(PG8_SB(1, 0), b3, voffB); PG8_STAGE(PG8_SB(1, 1), b3 + hstep, voffB); PG8_STAGE(PG8_SA(1, 0), a3, voffA);
            PG8_WAIT_V(8); PG8_WAIT_L(0); PG8_BAR; PG8_MMA(1, 0, At, B0); PG8_MMA(1, 1, At, B1); PG8_BAR; PG8_SCHED;
            } else {
            PG8_LDB(B0, 0, 0); PG8_SCHED; PG8_LDA(At, 0, 0); PG8_STAGE(PG8_SA(1, 1), a1 + hstep, voffA);
            PG8_WAIT_L(8); PG8_BAR; PG8_WAIT_L(0); PG8_MMA(0, 0, At, B0); PG8_BAR; PG8_SCHED;
            PG8_LDB(B1, 0, 1); PG8_STAGE(PG8_SB(0, 0), b2, voffB);
            PG8_BAR; PG8_WAIT_L(0); PG8_MMA(0, 1, At, B1); PG8_BAR;
            PG8_LDA(At, 0, 1); PG8_STAGE(PG8_SA(0, 0), a2, voffA);
            PG8_BAR; PG8_WAIT_L(0); PG8_MMA(1, 0, At, B0); PG8_BAR; PG8_SCHED;
            PG8_STAGE(PG8_SB(0, 1), b2 + hstep, voffB);
            PG8_WAIT_V(6); PG8_BAR; PG8_MMA(1, 1, At, B1); PG8_BAR;
            PG8_LDB(B0, 1, 0); PG8_SCHED; PG8_LDA(At, 1, 0); PG8_STAGE(PG8_SA(0, 1), a2 + hstep, voffA);
            PG8_WAIT_L(8); PG8_BAR; PG8_WAIT_L(0); PG8_MMA(0, 0, At, B0); PG8_BAR; PG8_SCHED;
            PG8_LDB(B1, 1, 1); PG8_STAGE(PG8_SB(1, 0), b3, voffB);
            PG8_BAR; PG8_WAIT_L(0); PG8_MMA(0, 1, At, B1); PG8_BAR;
            PG8_LDA(At, 1, 1); PG8_STAGE(PG8_SA(1, 0), a3, voffA);
            PG8_BAR; PG8_WAIT_L(0); PG8_MMA(1, 0, At, B0); PG8_BAR; PG8_SCHED;
            PG8_STAGE(PG8_SB(1, 1), b3 + hstep, voffB);
            PG8_WAIT_V(6); PG8_BAR; PG8_MMA(1, 1, At, B1); PG8_BAR;
            }
        }
        if constexpr (ALIGN_EPI) { if (wr == 0) PG8_BAR; }
        if constexpr (!Epi::AFTER_DRAIN) { E(acc, cur, wr, wc, fr, fq); S.done(cur); }
        if (!has_next) break;
#pragma unroll
        for (int a = 0; a < 2; ++a)
#pragma unroll
            for (int b = 0; b < 2; ++b)
#pragma unroll
                for (int m = 0; m < 4; ++m)
#pragma unroll
                    for (int n = 0; n < 2; ++n) acc[a][b][m][n] = (f32x4){0.f, 0.f, 0.f, 0.f};
        cur = nxt; cA = nA; cB = nB; ++ui;
        if constexpr (ALIGN_EPI) { if (wr == 1) PG8_BAR; }
    }
    PG8_WAIT_V(0);
    if constexpr (!ALIGN_EPI) { if (wr == 0) PG8_BAR; }
    PG8_BAR;
    if constexpr (Epi::AFTER_DRAIN) { E.fused(acc, cur, wr, wc, fr, fq, lds, wid, lane); S.done(cur); }
#undef PG8_SA
#undef PG8_SB
#undef PG8_STAGE
#undef PG8_LDA
#undef PG8_LDB
#undef PG8_MMA
#undef PG8_WAIT_V
#undef PG8_WAIT_L
#undef PG8_BAR
#undef PG8_SCHED
}
}
constexpr int M_TOK = 16384, SEQ = 8192, DM = 1024, DFF = 2816, NUP = 5632;
constexpr float RMS_EPS = 1e-6f;
constexpr float QC2 = 0.18033688011112042f;
constexpr size_t MiB = 1u << 20;
constexpr size_t WS_WIN = 0;
constexpr size_t WS_WA = 10 * MiB;
constexpr size_t WS_WB = 11 * MiB;
constexpr size_t WS_WOUT = 12 * MiB;
constexpr size_t WS_WUP = 14 * MiB;
constexpr size_t WS_WDN = 25 * MiB;
constexpr size_t WS_CS = 31 * MiB;
constexpr size_t WS_KMP = 33 * MiB;
constexpr size_t WS_SSQ = 34 * MiB;
constexpr size_t WS_HALO = 35 * MiB;
constexpr size_t WS_RAW = 38 * MiB;
constexpr size_t WS_XN = 41 * MiB;
constexpr size_t WS_QA = 73 * MiB;
constexpr size_t WS_KA = 89 * MiB;
constexpr size_t WS_QB = 105 * MiB;
constexpr size_t WS_KB = 121 * MiB;
constexpr size_t WS_VT = 137 * MiB;
constexpr size_t WS_G = 169 * MiB;
constexpr size_t WS_YA = 233 * MiB;
constexpr size_t WS_YB = 41 * MiB;
constexpr size_t WS_MRG = 57 * MiB;
constexpr size_t WS_X1B = 89 * MiB;
constexpr size_t WS_ACT = 121 * MiB;
constexpr size_t WS_END = 249 * MiB;

namespace pg8 {
__device__ __forceinline__ float sigmoidf_(float v) { return 1.0f / (1.0f + __expf(-v)); }
typedef unsigned u32x2 __attribute__((ext_vector_type(2)));

struct EpiPlain {
    static constexpr bool PERM = true, AFTER_DRAIN = false;
    bf16_t* O; int ldc; float scale;
    __device__ __forceinline__ void operator()(f32x4 (&acc)[2][2][4][2], const Unit& u, int wr, int wc, int fr, int fq) const {
        const int row0 = u.pm * BM + wr * 64 + fr, col0 = u.pn * BM + wc * 32 + 8 * fq;
#pragma unroll
        for (int ai = 0; ai < 2; ++ai)
#pragma unroll
            for (int m = 0; m < 4; ++m) { bf16_t* rowp = O + (size_t)(row0 + ai * HALF + m * 16) * ldc + col0;
#pragma unroll
                for (int bj = 0; bj < 2; ++bj) { const f32x4 v0 = acc[ai][bj][m][0] * scale, v1 = acc[ai][bj][m][1] * scale;
                    u32x4 w; w.x = cvt_pk_bf16(v0[0], v0[1]); w.y = cvt_pk_bf16(v0[2], v0[3]); w.z = cvt_pk_bf16(v1[0], v1[1]); w.w = cvt_pk_bf16(v1[2], v1[3]);
                    *(u32x4*)(rowp + bj * HALF) = w; } }
    }
};

struct EpiInProj {
    static constexpr bool PERM = true, AFTER_DRAIN = false;
    bf16_t *QA, *KA, *QB, *KB, *G; const float* bgate; const float* cs; float* kmp;
    __device__ __forceinline__ void operator()(f32x4 (&acc)[2][2][4][2], const Unit& u, int wr, int wc, int fr, int fq) const {
        const int row0 = u.pm * BM + wr * 64 + fr;
        if (u.pn < 4) {
            const bool isk = u.pn >= 2; bf16_t* O = isk ? KA : QA; const int pnl = u.pn & 1; const float sc = isk ? 1.0f : QC2;
            const int d0 = 16 * (wc & 1) + 4 * fq;
            f32x4 ks[2][2];
#pragma unroll
            for (int bj = 0; bj < 2; ++bj) { ks[bj][0] = (f32x4){0.f, 0.f, 0.f, 0.f}; ks[bj][1] = (f32x4){0.f, 0.f, 0.f, 0.f}; }
#pragma unroll
            for (int ai = 0; ai < 2; ++ai)
#pragma unroll
                for (int m = 0; m < 4; ++m) { const int row = row0 + ai * HALF + m * 16, pos = row & (SEQ - 1);
                    const f32x4 c = *(const f32x4*)(cs + (size_t)pos * 64 + d0), s = *(const f32x4*)(cs + (size_t)pos * 64 + 32 + d0);
#pragma unroll
                    for (int bj = 0; bj < 2; ++bj) { const f32x4 v0 = acc[ai][bj][m][0], v1 = acc[ai][bj][m][1];
                        f32x4 o1 = v0 * c - v1 * s, o2 = v1 * c + v0 * s;
                        ks[bj][0] += o1; ks[bj][1] += o2;
                        o1 = o1 * sc; o2 = o2 * sc;
                        const int head = 4 * pnl + 2 * bj + (wc >> 1);
                        bf16_t* p = O + (size_t)row * 512 + head * 64 + d0;
                        u32x2 w1, w2; w1.x = cvt_pk_bf16(o1[0], o1[1]); w1.y = cvt_pk_bf16(o1[2], o1[3]); w2.x = cvt_pk_bf16(o2[0], o2[1]); w2.y = cvt_pk_bf16(o2[2], o2[3]);
                        *(u32x2*)p = w1; *(u32x2*)(p + 32) = w2; } }
            if (isk) {
#pragma unroll
                for (int bj = 0; bj < 2; ++bj)
#pragma unroll
                    for (int hh = 0; hh < 2; ++hh) { f32x4 v = ks[bj][hh];
#pragma unroll
                        for (int o = 1; o < 16; o <<= 1) { v[0] += __shfl_xor(v[0], o); v[1] += __shfl_xor(v[1], o); v[2] += __shfl_xor(v[2], o); v[3] += __shfl_xor(v[3], o); }
                        if (fr == 0) { const int head = 4 * pnl + 2 * bj + (wc >> 1); *(f32x4*)(kmp + (size_t)(u.pm * 2 + wr) * 512 + head * 64 + hh * 32 + d0) = v; } }
            }
        } else if (u.pn < 8) {
            const bool isk = u.pn >= 6; bf16_t* O = isk ? KB : QB; const float sc = isk ? 1.0f : 0.125f;
            const int col0 = (u.pn & 1) * BM + wc * 32 + 8 * fq;
#pragma unroll
            for (int ai = 0; ai < 2; ++ai)
#pragma unroll
                for (int m = 0; m < 4; ++m) { bf16_t* rowp = O + (size_t)(row0 + ai * HALF + m * 16) * 512 + col0;
#pragma unroll
                    for (int bj = 0; bj < 2; ++bj) { const f32x4 v0 = acc[ai][bj][m][0] * sc, v1 = acc[ai][bj][m][1] * sc;
                        u32x4 w; w.x = cvt_pk_bf16(v0[0], v0[1]); w.y = cvt_pk_bf16(v0[2], v0[3]); w.z = cvt_pk_bf16(v1[0], v1[1]); w.w = cvt_pk_bf16(v1[2], v1[3]);
                        *(u32x4*)(rowp + bj * HALF) = w; } }
        } else {
            const int col0 = (u.pn - 8) * BM + wc * 32 + 8 * fq;
            f32x4 bv[2][2];
#pragma unroll
            for (int bj = 0; bj < 2; ++bj)
#pragma unroll
                for (int n = 0; n < 2; ++n) bv[bj][n] = *(const f32x4*)(bgate + col0 + bj * HALF + 4 * n);
#pragma unroll
            for (int ai = 0; ai < 2; ++ai)
#pragma unroll
                for (int m = 0; m < 4; ++m) { bf16_t* rowp = G + (size_t)(row0 + ai * HALF + m * 16) * 2048 + col0;
#pragma unroll
                    for (int bj = 0; bj < 2; ++bj) { f32x4 v0 = acc[ai][bj][m][0] + bv[bj][0], v1 = acc[ai][bj][m][1] + bv[bj][1];
#pragma unroll
                        for (int e = 0; e < 4; ++e) { v0[e] = sigmoidf_(v0[e]); v1[e] = sigmoidf_(v1[e]); }
                        u32x4 w; w.x = cvt_pk_bf16(v0[0], v0[1]); w.y = cvt_pk_bf16(v0[2], v0[3]); w.z = cvt_pk_bf16(v1[0], v1[1]); w.w = cvt_pk_bf16(v1[2], v1[3]);
                        *(u32x4*)(rowp + bj * HALF) = w; } }
        }
    }
};

__device__ __forceinline__ float bf_lo(unsigned w) { return __uint_as_float(w << 16); }
__device__ __forceinline__ float bf_hi(unsigned w) { return __uint_as_float(w & 0xffff0000u); }

template <int MODE> struct EpiBranch {
    static constexpr bool PERM = true, AFTER_DRAIN = false;
    bf16_t* MRG; const bf16_t* G;
    __device__ __forceinline__ void operator()(f32x4 (&acc)[2][2][4][2], const Unit& u, int wr, int wc, int fr, int fq) const {
        const int row0 = u.pm * BM + wr * 64 + fr, col0 = u.pn * BM + wc * 32 + 8 * fq;
#pragma unroll
        for (int ai = 0; ai < 2; ++ai)
#pragma unroll
            for (int m = 0; m < 4; ++m) { const size_t row = (size_t)(row0 + ai * HALF + m * 16);
#pragma unroll
                for (int bj = 0; bj < 2; ++bj) { const int col = col0 + bj * HALF;
                    const u32x4 g = *(const u32x4*)(G + row * 2048 + MODE * 1024 + col);
                    f32x4 v0 = acc[ai][bj][m][0], v1 = acc[ai][bj][m][1];
                    v0[0] *= bf_lo(g.x); v0[1] *= bf_hi(g.x); v0[2] *= bf_lo(g.y); v0[3] *= bf_hi(g.y);
                    v1[0] *= bf_lo(g.z); v1[1] *= bf_hi(g.z); v1[2] *= bf_lo(g.w); v1[3] *= bf_hi(g.w);
                    if (MODE == 1) { const u32x4 t = *(const u32x4*)(MRG + row * 1024 + col);
                        v0[0] += bf_lo(t.x); v0[1] += bf_hi(t.x); v0[2] += bf_lo(t.y); v0[3] += bf_hi(t.y);
                        v1[0] += bf_lo(t.z); v1[1] += bf_hi(t.z); v1[2] += bf_lo(t.w); v1[3] += bf_hi(t.w); }
                    u32x4 w; w.x = cvt_pk_bf16(v0[0], v0[1]); w.y = cvt_pk_bf16(v0[2], v0[3]); w.z = cvt_pk_bf16(v1[0], v1[1]); w.w = cvt_pk_bf16(v1[2], v1[3]);
                    *(u32x4*)(MRG + row * 1024 + col) = w; } }
    }
};

template <bool WITH_B> struct EpiResid {
    static constexpr bool PERM = true, AFTER_DRAIN = false;
    const float* XIN; float* XOUT; bf16_t* XB; float* ssq;
    __device__ __forceinline__ void operator()(f32x4 (&acc)[2][2][4][2], const Unit& u, int wr, int wc, int fr, int fq) const {
        const int row0 = u.pm * BM + wr * 64 + fr, col0 = u.pn * BM + wc * 32 + 8 * fq;
#pragma unroll
        for (int ai = 0; ai < 2; ++ai)
#pragma unroll
            for (int m = 0; m < 4; ++m) { const size_t row = (size_t)(row0 + ai * HALF + m * 16); float sq = 0.f;
#pragma unroll
                for (int bj = 0; bj < 2; ++bj) { const size_t off = row * DM + col0 + bj * HALF;
                    const f32x4 v0 = acc[ai][bj][m][0] + *(const f32x4*)(XIN + off), v1 = acc[ai][bj][m][1] + *(const f32x4*)(XIN + off + 4);
                    *(f32x4*)(XOUT + off) = v0; *(f32x4*)(XOUT + off + 4) = v1;
                    if (WITH_B) { sq += (v0[0] * v0[0] + v0[1] * v0[1]) + (v0[2] * v0[2] + v0[3] * v0[3]) + (v1[0] * v1[0] + v1[1] * v1[1]) + (v1[2] * v1[2] + v1[3] * v1[3]);
                        u32x4 w; w.x = cvt_pk_bf16(v0[0], v0[1]); w.y = cvt_pk_bf16(v0[2], v0[3]); w.z = cvt_pk_bf16(v1[0], v1[1]); w.w = cvt_pk_bf16(v1[2], v1[3]);
                        *(u32x4*)(XB + off) = w; } }
                if (WITH_B) { sq += __shfl_xor(sq, 16); sq += __shfl_xor(sq, 32); if (fq == 0) ssq[row * 16 + u.pn * 4 + wc] = sq; } }
    }
};

#define DPP_F(old_, src_, ctrl_) __uint_as_float((unsigned)__builtin_amdgcn_update_dpp((int)__float_as_uint(old_), (int)__float_as_uint(src_), ctrl_, 0xf, 0xf, false))
struct EpiUp {
    static constexpr bool PERM = true, AFTER_DRAIN = false;
    bf16_t* ACT; const float* ssq; const float* cw; const float* cb; float* halo; float* raw; PG8_LAS float* xl;
    __device__ __forceinline__ void operator()(f32x4 (&acc)[2][2][4][2], const Unit& u, int wr, int wc, int fr, int fq) const {
        const int row0 = u.pm * BM + wr * 64 + fr, tcol = wc * 32 + 8 * fq;
#pragma unroll
        for (int ai = 0; ai < 2; ++ai)
#pragma unroll
            for (int m = 0; m < 4; ++m) { const f32x4 p = *(const f32x4*)(ssq + (size_t)(row0 + ai * HALF + m * 16) * 16 + 4 * fq);
                float s = (p[0] + p[1]) + (p[2] + p[3]); s += __shfl_xor(s, 16); s += __shfl_xor(s, 32);
                const float rs = 1.0f / sqrtf(s * (1.0f / DM) + RMS_EPS);
#pragma unroll
                for (int bj = 0; bj < 2; ++bj) { acc[ai][bj][m][0] = acc[ai][bj][m][0] * rs; acc[ai][bj][m][1] = acc[ai][bj][m][1] * rs; } }
        if (fr >= 14) {
#pragma unroll
            for (int ai = 0; ai < 2; ++ai)
#pragma unroll
                for (int bj = 0; bj < 2; ++bj)
#pragma unroll
                    for (int n = 0; n < 2; ++n) { *(PG8_LAS f32x4*)(xl + ((ai * 2 + wr) * 2 + (fr - 14)) * 256 + bj * HALF + tcol + 4 * n) = acc[ai][bj][3][n];
                        if (ai == 1 && wr == 1) *(f32x4*)(halo + (size_t)(u.pm * 2 + (fr - 14)) * NUP + u.pn * BM + bj * HALF + tcol + 4 * n) = acc[1][bj][3][n]; }
        }
        if (fr < 2 && wr == 0) {
#pragma unroll
            for (int bj = 0; bj < 2; ++bj)
#pragma unroll
                for (int n = 0; n < 2; ++n) *(f32x4*)(raw + (size_t)(u.pm * 2 + fr) * NUP + u.pn * BM + bj * HALF + tcol + 4 * n) = acc[0][bj][0][n];
        }
        asm volatile("s_waitcnt lgkmcnt(0)" ::: "memory"); __builtin_amdgcn_s_barrier(); asm volatile("" ::: "memory");
        const int ch = u.pn * HALF + tcol;
        unsigned pk[2][4][2][2];
#pragma unroll
        for (int n = 0; n < 2; ++n) {
            f32x4 w0[2], w1[2], w2[2], bb[2];
#pragma unroll
            for (int bj = 0; bj < 2; ++bj) { const int c = bj * DFF + ch + 4 * n;
                w0[bj] = *(const f32x4*)(cw + c); w1[bj] = *(const f32x4*)(cw + NUP + c); w2[bj] = *(const f32x4*)(cw + 2 * NUP + c); bb[bj] = *(const f32x4*)(cb + c); }
#pragma unroll
            for (int ai = 0; ai < 2; ++ai) {
                f32x4 hv[2];
                const int src = ai * 2 + wr - 1;
#pragma unroll
                for (int bj = 0; bj < 2; ++bj) { hv[bj] = (f32x4){0.f, 0.f, 0.f, 0.f};
                    if (fr >= 14 && src >= 0) hv[bj] = *(const PG8_LAS f32x4*)(xl + (src * 2 + (fr - 14)) * 256 + bj * HALF + tcol + 4 * n); }
#pragma unroll
                for (int m = 0; m < 4; ++m) { f32x4 cv[2];
#pragma unroll
                    for (int bj = 0; bj < 2; ++bj) { const f32x4 cur = acc[ai][bj][m][n]; const f32x4 prv = (m == 0) ? hv[bj] : acc[ai][bj][m == 0 ? 0 : m - 1][n];
#pragma unroll
                        for (int e = 0; e < 4; ++e) {
                            const float r1 = DPP_F(0.f, prv[e], 0x121), r2 = DPP_F(0.f, prv[e], 0x122);
                            const float p1 = DPP_F(r1, cur[e], 0x111), p2 = DPP_F(r2, cur[e], 0x112);
                            cv[bj][e] = (w0[bj][e] * p2 + w1[bj][e] * p1) + (w2[bj][e] * cur[e] + bb[bj][e]); } }
                    float a[4];
#pragma unroll
                    for (int e = 0; e < 4; ++e) { const float g = cv[0][e]; a[e] = g * sigmoidf_(g) * cv[1][e]; }
                    pk[ai][m][n][0] = cvt_pk_bf16(a[0], a[1]); pk[ai][m][n][1] = cvt_pk_bf16(a[2], a[3]); }
            }
        }
#pragma unroll
        for (int ai = 0; ai < 2; ++ai)
#pragma unroll
            for (int m = 0; m < 4; ++m) { const bool skip = (ai == 0 && m == 0 && wr == 0 && fr < 2);
                u32x4 w; w.x = pk[ai][m][0][0]; w.y = pk[ai][m][0][1]; w.z = pk[ai][m][1][0]; w.w = pk[ai][m][1][1];
                if (!skip) *(u32x4*)(ACT + (size_t)(row0 + ai * HALF + m * 16) * DFF + ch) = w; }
    }
};
}
namespace att {
typedef unsigned short bf16_t;
typedef short bf16x8 __attribute__((ext_vector_type(8)));
typedef float f32x4 __attribute__((ext_vector_type(4)));
typedef unsigned u32x4 __attribute__((ext_vector_type(4)));
typedef unsigned u32x2 __attribute__((ext_vector_type(2)));
#define ATT_LAS __attribute__((address_space(3)))
__device__ __forceinline__ f32x4 mfma16(bf16x8 a, bf16x8 b, f32x4 c) { return __builtin_amdgcn_mfma_f32_16x16x32_bf16(a, b, c, 0, 0, 0); }
__device__ __forceinline__ unsigned cvtpk(float lo, float hi) { unsigned r; asm volatile("v_cvt_pk_bf16_f32 %0, %1, %2" : "=v"(r) : "v"(lo), "v"(hi)); return r; }
__device__ __forceinline__ int keyperm(int kk, int m) { return 32 * (kk >> 1) + 8 * (m >> 2) + 4 * (kk & 1) + (m & 3); }
__device__ __forceinline__ bf16x8 pack8(const f32x4& a, const f32x4& b) { u32x4 w; w.x = cvtpk(a[0], a[1]); w.y = cvtpk(a[2], a[3]); w.z = cvtpk(b[0], b[1]); w.w = cvtpk(b[2], b[3]); return __builtin_bit_cast(bf16x8, w); }

__device__ __forceinline__ void sb_unit(const bf16_t* QB, const bf16_t* KB, const bf16_t* VT, bf16_t* YB, int b, int h, int qg, int lane) {
    const int fr = lane & 15, fq = lane >> 4;
    const int t = qg * 16 + fr;
    const size_t rb = (size_t)b * SEQ;
    const bf16_t* qp = QB + (rb + t) * 512 + h * 64 + 8 * fq;
    const bf16x8 q0 = *(const bf16x8*)qp, q1 = *(const bf16x8*)(qp + 32);
    f32x4 o[4];
#pragma unroll
    for (int d = 0; d < 4; ++d) o[d] = (f32x4){0.f, 0.f, 0.f, 0.f};
    float carry = 0.f;
    const bf16_t* vbase = VT + (size_t)(512 + h * 64 + fr) * M_TOK + rb + 8 * fq;
    for (int kt = (qg * 16 + 15) >> 6; kt >= 0; --kt) {
        const int k0 = kt * 64;
        f32x4 s[4];
#pragma unroll
        for (int kk = 0; kk < 4; ++kk) { const bf16_t* kp = KB + (rb + k0 + keyperm(kk, fr)) * 512 + h * 64 + 8 * fq;
            const bf16x8 a0 = *(const bf16x8*)kp, a1 = *(const bf16x8*)(kp + 32);
            s[kk] = mfma16(a0, q0, (f32x4){0.f, 0.f, 0.f, 0.f}); s[kk] = mfma16(a1, q1, s[kk]); }
        float lm[4][4], ls[4][4];
#pragma unroll
        for (int kk = 0; kk < 4; ++kk)
#pragma unroll
            for (int e = 0; e < 4; ++e) { const int key = k0 + 32 * (kk >> 1) + 8 * fq + 4 * (kk & 1) + e; const float z = s[kk][e];
                const float sp = fmaxf(z, 0.f) + __logf(1.0f + __expf(-fabsf(z)));
                const bool ok = key < t; lm[kk][e] = ok ? -sp : 0.f; ls[kk][e] = ok ? (z - sp) : -INFINITY; }
        float tl = 0.f, th = 0.f;
#pragma unroll
        for (int e = 0; e < 4; ++e) { tl += lm[0][e]; th += lm[2][e]; }
#pragma unroll
        for (int e = 0; e < 4; ++e) { tl += lm[1][e]; th += lm[3][e]; }
        float tlj[4], thj[4];
#pragma unroll
        for (int j = 0; j < 4; ++j) { tlj[j] = __shfl(tl, fr + 16 * j); thj[j] = __shfl(th, fr + 16 * j); }
        const float TH = (thj[0] + thj[1]) + (thj[2] + thj[3]), TL = (tlj[0] + tlj[1]) + (tlj[2] + tlj[3]);
        float ah = carry, al = carry + TH;
#pragma unroll
        for (int j = 3; j >= 1; --j) { if (fq < j) { ah += thj[j]; al += tlj[j]; } }
        f32x4 a[4];
        float run = ah;
#pragma unroll
        for (int kk = 3; kk >= 2; --kk)
#pragma unroll
            for (int e = 3; e >= 0; --e) { a[kk][e] = __expf(ls[kk][e] + run); run += lm[kk][e]; }
        run = al;
#pragma unroll
        for (int kk = 1; kk >= 0; --kk)
#pragma unroll
            for (int e = 3; e >= 0; --e) { a[kk][e] = __expf(ls[kk][e] + run); run += lm[kk][e]; }
        carry += TH + TL;
        const bf16x8 p0 = pack8(a[0], a[1]), p1 = pack8(a[2], a[3]);
#pragma unroll
        for (int dt = 0; dt < 4; ++dt) { const bf16_t* vp = vbase + (size_t)(16 * dt) * M_TOK + k0;
            const bf16x8 v0 = *(const bf16x8*)vp, v1 = *(const bf16x8*)(vp + 32);
            o[dt] = mfma16(v0, p0, o[dt]); o[dt] = mfma16(v1, p1, o[dt]); }
        if (__all(carry < -110.0f)) break;
    }
    bf16_t* yp = YB + (rb + t) * 512 + h * 64 + 4 * fq;
#pragma unroll
    for (int dt = 0; dt < 4; ++dt) { u32x2 w; w.x = cvtpk(o[dt][0], o[dt][1]); w.y = cvtpk(o[dt][2], o[dt][3]); *(u32x2*)(yp + 16 * dt) = w; }
}

__device__ __forceinline__ void moba_item(const bf16_t* QA, const bf16_t* KA, const bf16_t* VT, size_t rb, int h, int i, int j, int qidx, bool causal, int qmax, bool first,
                                          ATT_LAS float* st_m, ATT_LAS float* st_l, ATT_LAS float* st_o, int lane) {
    const int fr = lane & 15, fq = lane >> 4;
    const bool valid = qidx >= 0; const int q = valid ? qidx : 0;
    const bf16_t* qp = QA + (rb + 256 * i + q) * 512 + h * 64 + 8 * fq;
    const bf16x8 q0 = *(const bf16x8*)qp, q1 = *(const bf16x8*)(qp + 32);
    const bf16_t* kb = KA + (rb + 256 * j) * 512 + h * 64 + 8 * fq;
    f32x4 s[16];
#pragma unroll
    for (int kk = 0; kk < 16; ++kk) {
        if (32 * (kk >> 1) <= qmax) { const bf16_t* kp = kb + (size_t)keyperm(kk, fr) * 512;
            const bf16x8 a0 = *(const bf16x8*)kp, a1 = *(const bf16x8*)(kp + 32);
            s[kk] = mfma16(a0, q0, (f32x4){0.f, 0.f, 0.f, 0.f}); s[kk] = mfma16(a1, q1, s[kk]);
        } else s[kk] = (f32x4){-INFINITY, -INFINITY, -INFINITY, -INFINITY};
    }
    if (causal) {
#pragma unroll
        for (int kk = 0; kk < 16; ++kk)
#pragma unroll
            for (int e = 0; e < 4; ++e) { const int key = 32 * (kk >> 1) + 8 * fq + 4 * (kk & 1) + e; if (key > q) s[kk][e] = -INFINITY; }
    }
    float mb = -INFINITY;
#pragma unroll
    for (int kk = 0; kk < 16; ++kk) mb = fmaxf(mb, fmaxf(fmaxf(s[kk][0], s[kk][1]), fmaxf(s[kk][2], s[kk][3])));
    mb = fmaxf(mb, __shfl_xor(mb, 16)); mb = fmaxf(mb, __shfl_xor(mb, 32));
    float lb = 0.f;
#pragma unroll
    for (int kk = 0; kk < 16; ++kk)
#pragma unroll
        for (int e = 0; e < 4; ++e) { const float p = __builtin_amdgcn_exp2f(s[kk][e] - mb); s[kk][e] = p; lb += p; }
    lb += __shfl_xor(lb, 16); lb += __shfl_xor(lb, 32);
    f32x4 o[4];
#pragma unroll
    for (int d = 0; d < 4; ++d) o[d] = (f32x4){0.f, 0.f, 0.f, 0.f};
    const bf16_t* vb = VT + (size_t)(h * 64 + fr) * M_TOK + rb + 256 * j + 8 * fq;
#pragma unroll
    for (int ks = 0; ks < 8; ++ks) {
        if (32 * ks <= qmax) { const bf16x8 p = pack8(s[2 * ks], s[2 * ks + 1]);
#pragma unroll
            for (int dt = 0; dt < 4; ++dt) { const bf16x8 v = *(const bf16x8*)(vb + (size_t)(16 * dt) * M_TOK + 32 * ks); o[dt] = mfma16(v, p, o[dt]); } }
    }
    if (valid) {
        ATT_LAS float* so = st_o + q * 68 + 4 * fq;
        if (first) {
            if (fq == 0) { st_m[q] = mb; st_l[q] = lb; }
#pragma unroll
            for (int dt = 0; dt < 4; ++dt) *(ATT_LAS f32x4*)(so + 16 * dt) = o[dt];
        } else {
            const float mo = st_m[q], lo = st_l[q]; const float mn = fmaxf(mo, mb);
            const float ca = __builtin_amdgcn_exp2f(mo - mn), cb2 = __builtin_amdgcn_exp2f(mb - mn);
            f32x4 oo[4];
#pragma unroll
            for (int dt = 0; dt < 4; ++dt) oo[dt] = *(const ATT_LAS f32x4*)(so + 16 * dt);
#pragma unroll
            for (int dt = 0; dt < 4; ++dt) *(ATT_LAS f32x4*)(so + 16 * dt) = oo[dt] * ca + o[dt] * cb2;
            if (fq == 0) { st_m[q] = mn; st_l[q] = lo * ca + lb * cb2; }
        }
    }
}

constexpr int L_KM = 0;
constexpr int L_CAND = 8192;
constexpr int L_SEL = 20480;
constexpr int L_CNT = 23552;
constexpr int L_LIST = 24576;
constexpr int L_STM = 49152;
constexpr int L_STL = 50176;
constexpr int L_STO = 51200;

__device__ __forceinline__ void wg_bar() { asm volatile("s_waitcnt vmcnt(0) lgkmcnt(0)" ::: "memory"); __builtin_amdgcn_s_barrier(); asm volatile("" ::: "memory"); }

__device__ __forceinline__ void moba_unit(ATT_LAS unsigned char* lds, const bf16_t* QA, const bf16_t* KA, const bf16_t* VT, const float* KMP, bf16_t* YA, int b, int h, int i) {
    const int tid = threadIdx.x, lane = tid & 63, wid = __builtin_amdgcn_readfirstlane(tid >> 6);
    ATT_LAS float* km = (ATT_LAS float*)(lds + L_KM);
    ATT_LAS float* candv = (ATT_LAS float*)(lds + L_CAND); ATT_LAS int* candi = (ATT_LAS int*)(lds + L_CAND + 6144);
    ATT_LAS int* sel = (ATT_LAS int*)(lds + L_SEL); ATT_LAS int* cnt = (ATT_LAS int*)(lds + L_CNT);
    ATT_LAS unsigned char* list = (ATT_LAS unsigned char*)(lds + L_LIST);
    ATT_LAS float* st_m = (ATT_LAS float*)(lds + L_STM); ATT_LAS float* st_l = (ATT_LAS float*)(lds + L_STL); ATT_LAS float* st_o = (ATT_LAS float*)(lds + L_STO);
    const size_t rb = (size_t)b * SEQ;
    wg_bar();
    for (int idx = tid; idx < i * 64; idx += 512) { const int j = idx >> 6, d = idx & 63; const float* p = KMP + (size_t)((b * 32 + j) * 2) * 512 + h * 64 + d; km[idx] = (p[0] + p[512]) * (1.0f / 256.0f); }
    if (tid < 96) cnt[tid] = 0;
    wg_bar();
    {
        const int q = tid & 255, half = tid >> 8;
        const bf16_t* qp = QA + (rb + 256 * i + q) * 512 + h * 64;
        float qf[64];
#pragma unroll
        for (int c = 0; c < 8; ++c) { const u32x4 w = *(const u32x4*)(qp + 8 * c);
            qf[8 * c + 0] = __uint_as_float(w.x << 16); qf[8 * c + 1] = __uint_as_float(w.x & 0xffff0000u); qf[8 * c + 2] = __uint_as_float(w.y << 16); qf[8 * c + 3] = __uint_as_float(w.y & 0xffff0000u);
            qf[8 * c + 4] = __uint_as_float(w.z << 16); qf[8 * c + 5] = __uint_as_float(w.z & 0xffff0000u); qf[8 * c + 6] = __uint_as_float(w.w << 16); qf[8 * c + 7] = __uint_as_float(w.w & 0xffff0000u); }
        float v0 = -INFINITY, v1 = -INFINITY, v2 = -INFINITY; int i0 = -1, i1 = -1, i2 = -1;
        const int jlo = 16 * half, jhi = (i < jlo + 16) ? i : jlo + 16;
        for (int j = jlo; j < jhi; ++j) {
            const ATT_LAS f32x4* kr = (const ATT_LAS f32x4*)(km + j * 64);
            float g0 = 0.f, g1 = 0.f, g2 = 0.f, g3 = 0.f;
#pragma unroll
            for (int c = 0; c < 16; ++c) { const f32x4 kv = kr[c]; g0 = fmaf(qf[4 * c], kv[0], g0); g1 = fmaf(qf[4 * c + 1], kv[1], g1); g2 = fmaf(qf[4 * c + 2], kv[2], g2); g3 = fmaf(qf[4 * c + 3], kv[3], g3); }
            const float g = (g0 + g1) + (g2 + g3);
            if (g > v0) { v2 = v1; i2 = i1; v1 = v0; i1 = i0; v0 = g; i0 = j; }
            else if (g > v1) { v2 = v1; i2 = i1; v1 = g; i1 = j; }
            else if (g > v2) { v2 = g; i2 = j; }
        }
        const int cb = (half * 256 + q) * 3;
        candv[cb] = v0; candv[cb + 1] = v1; candv[cb + 2] = v2; candi[cb] = i0; candi[cb + 1] = i1; candi[cb + 2] = i2;
    }
    wg_bar();
    if (tid < 256) {
        const int q = tid; float av[3], bv[3]; int ax[3], bx[3];
#pragma unroll
        for (int r = 0; r < 3; ++r) { av[r] = candv[q * 3 + r]; ax[r] = candi[q * 3 + r]; bv[r] = candv[(256 + q) * 3 + r]; bx[r] = candi[(256 + q) * 3 + r]; }
        int pa = 0, pb = 0;
#pragma unroll
        for (int r = 0; r < 3; ++r) {
            const float va = pa == 0 ? av[0] : pa == 1 ? av[1] : pa == 2 ? av[2] : -INFINITY; const int xa = pa == 0 ? ax[0] : pa == 1 ? ax[1] : pa == 2 ? ax[2] : -1;
            const float vb = pb == 0 ? bv[0] : pb == 1 ? bv[1] : pb == 2 ? bv[2] : -INFINITY; const int xb = pb == 0 ? bx[0] : pb == 1 ? bx[1] : pb == 2 ? bx[2] : -1;
            int pick;
            if (xa >= 0 && (xb < 0 || va >= vb)) { pick = xa; ++pa; } else if (xb >= 0) { pick = xb; ++pb; } else pick = -1;
            sel[q * 3 + r] = pick;
            if (pick >= 0) { const int slot = atomicAdd((int*)&cnt[r * 32 + pick], 1); list[(r * 32 + pick) * 256 + slot] = (unsigned char)q; }
        }
    }
    wg_bar();
    for (int ph = 0; ph < 4; ++ph) {
        int total, incl = 0, nl = 0;
        if (ph == 0) total = 16;
        else { if (lane < 32) nl = (cnt[(ph - 1) * 32 + lane] + 15) >> 4; incl = nl;
#pragma unroll
            for (int o = 1; o < 32; o <<= 1) { const int t = __shfl_up(incl, o); if ((lane & 31) >= o) incl += t; }
            total = __builtin_amdgcn_readfirstlane(__shfl(incl, 31)); }
        for (int k = wid; k < total; k += 8) {
            int j, qidx, qmax; bool causal;
            if (ph == 0) { j = i; qidx = 16 * k + (lane & 15); qmax = 16 * k + 15; causal = true; }
            else { const unsigned long long bm = __ballot(lane < 32 && incl > k); j = __builtin_amdgcn_readfirstlane((int)__builtin_ctzll(bm));
                const int excl = __builtin_amdgcn_readfirstlane(__shfl(incl - nl, j)); const int grp = k - excl; const int n = cnt[(ph - 1) * 32 + j];
                const int pos = grp * 16 + (lane & 15); qidx = pos < n ? (int)list[((ph - 1) * 32 + j) * 256 + pos] : -1; qmax = 255; causal = false; }
            moba_item(QA, KA, VT, rb, h, i, j, qidx, causal, qmax, ph == 0, st_m, st_l, st_o, lane);
        }
        wg_bar();
    }
    { const int q = tid >> 1, hf = tid & 1; const float rl = 1.0f / st_l[q]; const ATT_LAS float* so = st_o + q * 68 + 32 * hf;
      bf16_t* yp = YA + (rb + 256 * i + q) * 512 + h * 64 + 32 * hf;
#pragma unroll
      for (int c = 0; c < 4; ++c) { const f32x4 a = *(const ATT_LAS f32x4*)(so + 8 * c) * rl, bq = *(const ATT_LAS f32x4*)(so + 8 * c + 4) * rl;
          u32x4 w; w.x = cvtpk(a[0], a[1]); w.y = cvtpk(a[2], a[3]); w.z = cvtpk(bq[0], bq[1]); w.w = cvtpk(bq[2], bq[3]); *(u32x4*)(yp + 8 * c) = w; } }
}
}
#define LAS __attribute__((address_space(3)))
typedef unsigned short bf16;
typedef unsigned v4u __attribute__((ext_vector_type(4)));
typedef float f32x4 __attribute__((ext_vector_type(4)));
constexpr int NWAVES = 8;
constexpr int RING_BYTES = 131072, EXCH_OFF = RING_BYTES, LDS_BYTES = 147456;
__device__ __forceinline__ unsigned f2bf(float f) { unsigned u = __builtin_bit_cast(unsigned, f); return (u + 0x7fffu + ((u >> 16) & 1u)) >> 16; }
__device__ __forceinline__ unsigned pk2(float lo, float hi) { return f2bf(lo) | (f2bf(hi) << 16); }
__device__ __forceinline__ float wave_sum(float v) {
#pragma unroll
    for (int o = 1; o < 64; o <<= 1) v += __shfl_xor(v, o);
    return v;
}
__device__ __forceinline__ int map_win(int c) {
    if (c < 1024) { const int reg = c >> 9, cc = c & 511, head = cc >> 6, d = cc & 63; const int pp = 8 * ((d >> 2) & 7) + 4 * (d >> 5) + (d & 3); return reg * 512 + head * 64 + pp; }
    if (c < 1536) return 4096 + (c - 1024);
    if (c < 2048) return 1024 + (c - 1536);
    if (c < 2560) return 1536 + (c - 2048);
    if (c < 3072) return 4608 + (c - 2560);
    return 2048 + (c - 3072);
}
__device__ __forceinline__ int map_wup(int c) { const int v = c >= DFF ? 1 : 0, cc = c - v * DFF; return 256 * (cc >> 7) + 128 * v + (cc & 127); }
template <int MAP> __device__ __forceinline__ void transpose_item(const float* W, int K, int N, bf16* WT, const float* kscale, LAS float* scr, int item, int lane) {
    const int nblk = N / 32, kb = item / nblk, nb = item % nblk, k0 = 64 * kb, n0 = 32 * nb;
#pragma unroll 8
    for (int i = 0; i < 32; ++i) { const int kk = 2 * i + (lane >> 5); float v = W[(size_t)(k0 + kk) * N + n0 + (lane & 31)]; if (kscale) v *= kscale[k0 + kk]; scr[kk * 33 + (lane & 31)] = v; }
    asm volatile("s_waitcnt lgkmcnt(0)" ::: "memory");
    const int c = lane & 7;
#pragma unroll
    for (int j = 0; j < 4; ++j) { const int n = (lane >> 3) + 8 * j; const LAS float* s = scr + (8 * c) * 33 + n;
        v4u o; o.x = pk2(s[0 * 33], s[1 * 33]); o.y = pk2(s[2 * 33], s[3 * 33]); o.z = pk2(s[4 * 33], s[5 * 33]); o.w = pk2(s[6 * 33], s[7 * 33]);
        const int sc = n0 + n; const int row = MAP == 1 ? map_win(sc) : MAP == 2 ? map_wup(sc) : sc;
        *(v4u*)(WT + (size_t)row * K + k0 + 8 * c) = o; }
    asm volatile("s_waitcnt lgkmcnt(0)" ::: "memory");
}
__device__ __forceinline__ void rms_row_bf16(const float* xrow, const float* g, bf16* orow, int lane) {
    const f32x4* xr = (const f32x4*)xrow + lane; const f32x4* gr = (const f32x4*)g + lane;
    f32x4 v[4]; float s = 0.f;
#pragma unroll
    for (int j = 0; j < 4; ++j) { v[j] = xr[64 * j]; s += (v[j][0] * v[j][0] + v[j][1] * v[j][1]) + (v[j][2] * v[j][2] + v[j][3] * v[j][3]); }
    const float rstd = 1.0f / sqrtf(wave_sum(s) * (1.0f / DM) + RMS_EPS);
    unsigned long long* o8 = (unsigned long long*)orow + lane;
#pragma unroll
    for (int j = 0; j < 4; ++j) { const f32x4 gg = gr[64 * j]; o8[64 * j] = (unsigned long long)pk2(v[j][0] * rstd * gg[0], v[j][1] * rstd * gg[1]) | ((unsigned long long)pk2(v[j][2] * rstd * gg[2], v[j][3] * rstd * gg[3]) << 32); }
}
__device__ __forceinline__ void rms_row_f32(float* xrow, const float* g, int lane) {
    f32x4* xr = (f32x4*)xrow + lane; const f32x4* gr = (const f32x4*)g + lane;
    f32x4 v[4]; float s = 0.f;
#pragma unroll
    for (int j = 0; j < 4; ++j) { v[j] = xr[64 * j]; s += (v[j][0] * v[j][0] + v[j][1] * v[j][1]) + (v[j][2] * v[j][2] + v[j][3] * v[j][3]); }
    const float rstd = 1.0f / sqrtf(wave_sum(s) * (1.0f / DM) + RMS_EPS);
#pragma unroll
    for (int j = 0; j < 4; ++j) xr[64 * j] = v[j] * rstd * gr[64 * j];
}

struct Args { const float* in[13]; float* out; unsigned char* ws; };

__global__ void __launch_bounds__(NWAVES * 64, 2) mega_fwd(Args args) {
    extern __shared__ __attribute__((aligned(16))) unsigned char lds_raw[];
    cg::grid_group grid = cg::this_grid();
    LAS unsigned char* lds = (LAS unsigned char*)lds_raw;
    const int tid = threadIdx.x, lane = tid & 63, wave = __builtin_amdgcn_readfirstlane(tid >> 6);
    const int G = gridDim.x, bx = blockIdx.x;
    const float* x = args.in[0]; const float* g_mix = args.in[1]; const float* w_in = args.in[2]; const float* b_gate = args.in[3];
    const float* w_a = args.in[4]; const float* w_b = args.in[5]; const float* w_out = args.in[6]; const float* g_ffn = args.in[7];
    const float* w_up = args.in[8]; const float* conv_w = args.in[9]; const float* conv_b = args.in[10]; const float* w_down = args.in[11]; const float* g_final = args.in[12];
    float* out = args.out; unsigned char* ws = args.ws;
    bf16 *Win = (bf16*)(ws + WS_WIN), *Wa = (bf16*)(ws + WS_WA), *Wb = (bf16*)(ws + WS_WB), *Wout = (bf16*)(ws + WS_WOUT), *Wup = (bf16*)(ws + WS_WUP), *Wdn = (bf16*)(ws + WS_WDN);
    float *CS = (float*)(ws + WS_CS), *KMP = (float*)(ws + WS_KMP), *SSQ = (float*)(ws + WS_SSQ), *HALO = (float*)(ws + WS_HALO), *RAW = (float*)(ws + WS_RAW);
    bf16 *XN = (bf16*)(ws + WS_XN), *QA = (bf16*)(ws + WS_QA), *KA = (bf16*)(ws + WS_KA), *QB = (bf16*)(ws + WS_QB), *KB = (bf16*)(ws + WS_KB), *VT = (bf16*)(ws + WS_VT), *GT = (bf16*)(ws + WS_G);
    bf16 *YA = (bf16*)(ws + WS_YA), *YB = (bf16*)(ws + WS_YB), *MRG = (bf16*)(ws + WS_MRG), *X1B = (bf16*)(ws + WS_X1B), *ACT = (bf16*)(ws + WS_ACT);

    {
        LAS float* scr = (LAS float*)(lds + wave * 16384);
        const int gw = bx * NWAVES + wave, NGW = G * NWAVES;
        constexpr int I_IN = (DM / 64) * (5120 / 32), I_A = (512 / 64) * (DM / 32), I_O = (DM / 64) * (DM / 32), I_UP = (DM / 64) * (NUP / 32), I_DN = (DFF / 64) * (DM / 32);
        constexpr int NITEMS = I_IN + 2 * I_A + I_O + I_UP + I_DN;
        for (int it = gw; it < NITEMS; it += NGW) {
            int r = it;
            if (r < I_IN) { transpose_item<1>(w_in, DM, 5120, Win, nullptr, scr, r, lane); continue; } r -= I_IN;
            if (r < I_A) { transpose_item<0>(w_a, 512, DM, Wa, nullptr, scr, r, lane); continue; } r -= I_A;
            if (r < I_A) { transpose_item<0>(w_b, 512, DM, Wb, nullptr, scr, r, lane); continue; } r -= I_A;
            if (r < I_O) { transpose_item<0>(w_out, DM, DM, Wout, nullptr, scr, r, lane); continue; } r -= I_O;
            if (r < I_UP) { transpose_item<2>(w_up, DM, NUP, Wup, g_ffn, scr, r, lane); continue; } r -= I_UP;
            transpose_item<0>(w_down, DFF, DM, Wdn, nullptr, scr, r, lane);
        }
        for (int m = gw; m < M_TOK; m += NGW) rms_row_bf16(x + (size_t)m * DM, g_mix, XN + (size_t)m * DM, lane);
        for (int e = bx * 512 + tid; e < SEQ * 32; e += G * 512) { const int pos = e >> 5, fi = e & 31;
            double inv = 1.0; for (int k = 0; k < fi; ++k) inv *= 0.7498942093324558;
            const float ang = (float)pos * (float)inv; const double rv = (double)ang * 0.15915494309189535; const float fr_ = (float)(rv - __builtin_rint(rv));
            CS[(size_t)pos * 64 + fi] = __builtin_amdgcn_cosf(fr_); CS[(size_t)pos * 64 + 32 + fi] = __builtin_amdgcn_sinf(fr_); }
    }
    grid.sync();
    {
        pg8::Gemm g{XN, Win, M_TOK, 4096, DM}; pg8::StaticOrder S; S.init(M_TOK, 4096, G, bx);
        pg8::EpiInProj E{QA, KA, QB, KB, GT, b_gate, CS, KMP};
        pg8::gemm_phase<pg8::EpiInProj, pg8::StaticOrder, true, true>(lds, g, S, E);
        pg8::Gemm g2{Win + (size_t)4096 * DM, XN, 1024, M_TOK, DM}; pg8::StaticOrder S2; S2.init(1024, M_TOK, G, bx);
        pg8::EpiPlain E2{VT, M_TOK, 1.0f};
        pg8::gemm_phase<pg8::EpiPlain, pg8::StaticOrder, true, true>(lds, g2, S2, E2);
    }
    grid.sync();
    {
        for (int n = bx; n < 512; n += G) { const int c = n & 255, bh = c >> 4, s = c & 15; const int i = (n < 256) ? s : 31 - s;
            att::moba_unit(lds, QA, KA, VT, KMP, YA, bh >> 3, bh & 7, i); }
        const int gw = bx * NWAVES + wave, NGW = G * NWAVES;
        for (int un = gw; un < 8192; un += NGW) { const int bh = un >> 9, qg = un & 511; att::sb_unit(QB, KB, VT, YB, bh >> 3, bh & 7, qg, lane); }
    }
    grid.sync();
    {
        pg8::Gemm g{YA, Wa, M_TOK, DM, 512}; pg8::StaticOrder S; S.init(M_TOK, DM, G, bx);
        pg8::EpiBranch<0> E{MRG, GT};
        pg8::gemm_phase<pg8::EpiBranch<0>, pg8::StaticOrder, true, true>(lds, g, S, E);
        pg8::Gemm g2{YB, Wb, M_TOK, DM, 512};
        pg8::EpiBranch<1> E2{MRG, GT};
        pg8::gemm_phase<pg8::EpiBranch<1>, pg8::StaticOrder, true, true>(lds, g2, S, E2);
    }
    grid.sync();
    {
        pg8::Gemm g{MRG, Wout, M_TOK, DM, DM}; pg8::StaticOrder S; S.init(M_TOK, DM, G, bx);
        pg8::EpiResid<true> E{x, out, X1B, SSQ};
        pg8::gemm_phase<pg8::EpiResid<true>, pg8::StaticOrder, true, true>(lds, g, S, E);
    }
    grid.sync();
    {
        pg8::Gemm g{X1B, Wup, M_TOK, NUP, DM}; pg8::StaticOrder S; S.init(M_TOK, NUP, G, bx);
        pg8::EpiUp E{ACT, SSQ, conv_w, conv_b, HALO, RAW, (LAS float*)(lds + EXCH_OFF)};
        pg8::gemm_phase<pg8::EpiUp, pg8::StaticOrder, true, true>(lds, g, S, E);
    }
    grid.sync();
    {
        pg8::StaticOrder S; S.init(M_TOK, DM, G, bx); pg8::Unit u;
        for (int ui = 0; S.next(ui, u); ++ui) {
            const int pm = u.pm; const bool hasprev = (pm & 31) != 0;
            for (int idx = tid; idx < 2 * DFF; idx += 512) { const int r = idx >= DFF ? 1 : 0, c = idx - r * DFF; const int gc = 256 * (c >> 7) + (c & 127);
                float a2[2];
#pragma unroll
                for (int v = 0; v < 2; ++v) { const int tc = gc + 128 * v, cc = c + v * DFF;
                    const float h0 = hasprev ? HALO[(size_t)((pm - 1) * 2 + 0) * NUP + tc] : 0.f, h1 = hasprev ? HALO[(size_t)((pm - 1) * 2 + 1) * NUP + tc] : 0.f;
                    const float r0 = RAW[(size_t)(pm * 2 + 0) * NUP + tc], r1 = RAW[(size_t)(pm * 2 + 1) * NUP + tc];
                    const float cur = r ? r1 : r0, p1 = r ? r0 : h1, p2 = r ? h1 : h0;
                    a2[v] = (conv_w[cc] * p2 + conv_w[NUP + cc] * p1) + (conv_w[2 * NUP + cc] * cur + conv_b[cc]); }
                const float act = a2[0] * pg8::sigmoidf_(a2[0]) * a2[1];
                ACT[(size_t)(pm * 256 + r) * DFF + c] = (bf16)f2bf(act); }
        }
        __threadfence(); __syncthreads(); __builtin_amdgcn_fence(__ATOMIC_ACQUIRE, "agent"); asm volatile("s_waitcnt vmcnt(0)" ::: "memory"); __syncthreads();
        pg8::Gemm g{ACT, Wdn, M_TOK, DM, DFF};
        pg8::EpiResid<false> E{out, out, nullptr, nullptr};
        pg8::gemm_phase<pg8::EpiResid<false>, pg8::StaticOrder, true, true>(lds, g, S, E);
    }
    grid.sync();
    {
        const int gw = bx * NWAVES + wave, NGW = G * NWAVES;
        for (int m = gw; m < M_TOK; m += NGW) rms_row_f32(out + (size_t)m * DM, g_final, lane);
    }
}

extern "C" void kernel_launch(void* const* d_in, const int* in_sizes, int n_in, void* d_out, int out_size, void* d_ws, size_t ws_size, hipStream_t stream) {
    static int grid = 0;
    if (grid == 0) {
        if (n_in != 13 || out_size != M_TOK * DM || ws_size < WS_END) { fprintf(stderr, "kernel_launch: unexpected shapes (n_in %d out %d ws %zu)\n", n_in, out_size, ws_size); grid = -1; return; }
        int dev = 0, cus = 0, per_cu = 0;
        hipGetDevice(&dev); hipDeviceGetAttribute(&cus, hipDeviceAttributeMultiprocessorCount, dev);
        hipFuncSetAttribute((const void*)mega_fwd, hipFuncAttributeMaxDynamicSharedMemorySize, LDS_BYTES);
        if (hipOccupancyMaxActiveBlocksPerMultiprocessor(&per_cu, (const void*)mega_fwd, NWAVES * 64, LDS_BYTES) != hipSuccess || per_cu < 1) { fprintf(stderr, "kernel_launch: occupancy query says %d\n", per_cu); per_cu = 1; }
        (void)hipGetLastError();
        grid = cus * 1;
    }
    if (grid < 0) return;
    Args a{};
    for (int i = 0; i < 13; ++i) a.in[i] = (const float*)d_in[i];
    a.out = (float*)d_out; a.ws = (unsigned char*)d_ws;
    void* params[] = {&a};
    hipError_t e = hipLaunchCooperativeKernel((const void*)mega_fwd, dim3(grid), dim3(NWAVES * 64), params, LDS_BYTES, stream);
    if (e != hipSuccess) fprintf(stderr, "cooperative launch failed: %s (grid %d)\n", hipGetErrorString(e), grid);
}
```

```cpp
#include <hip/hip_runtime.h>
#include <hip/hip_cooperative_groups.h>
#include <cstdio>
#include <cstdint>
namespace cg = cooperative_groups;
namespace pg8 {
#define PG8_LAS __attribute__((address_space(3)))
typedef unsigned short bf16_t;
typedef short bf16x8 __attribute__((ext_vector_type(8)));
typedef float f32x4 __attribute__((ext_vector_type(4)));
typedef unsigned u32x4 __attribute__((ext_vector_type(4)));
constexpr int BM = 256, BK = 64, HALF = 128, HTB = HALF * BK * 2  , STAGE_BYTES = 8 * HTB, NXCD = 8, WGM = 8;

__host__ __device__ __forceinline__ int lds_byte(int r, int c) { const int st = (r >> 4) * 2 + (c >> 5), rr = r & 15, cc = c & 31, ob = rr * 64 + cc * 2; return st * 1024 + (ob ^ (((ob >> 9) & 1) << 5)); }
__host__ __device__ __forceinline__ void stage_rc(int b, int& R, int& C) { const int st = b / 1024, sb = b % 1024, swz = sb ^ (((sb >> 9) & 1) << 5); R = (st >> 1) * 16 + swz / 64; C = (st & 1) * 32 + (swz % 64) / 2; }
__host__ __device__ __forceinline__ int perm32(int rho) { const int n = rho >> 4, i = rho & 15; return 8 * (i >> 2) + 4 * n + (i & 3); }

struct Unit { int pm, pn; };
struct Gemm { const bf16_t* A; const bf16_t* Bt; int M, N, K; };

struct StaticOrder {
    int nM, nN, nwg, G, c;
    __host__ __device__ void init(int M, int N, int G_, int c_) { nM = M / BM; nN = N / BM; nwg = nM * nN; G = G_; c = c_; }
    __host__ __device__ bool next(int i, Unit& u) const {
        const long L = (long)i * G + c; if (L >= nwg) return false;
        int wgid = (int)L; { const int q = nwg / NXCD, r = nwg % NXCD, xcd = wgid % NXCD, off = wgid / NXCD; wgid = (xcd < r ? xcd * (q + 1) : r * (q + 1) + (xcd - r) * q) + off; }
        const int nig = WGM * nN, gid = wgid / nig, fm = gid * WGM, gsz = (nM - fm) < WGM ? (nM - fm) : WGM;
        u.pm = fm + ((wgid % nig) % gsz); u.pn = (wgid % nig) / gsz; return true;
    }
    __device__ __forceinline__ void a_ready(const Unit&) const {}
    __device__ __forceinline__ void done(const Unit&) const {}
};

typedef float f32x2c_t __attribute__((ext_vector_type(2))); typedef __bf16 bf16x2c_t __attribute__((ext_vector_type(2)));
__device__ __forceinline__ unsigned cvt_pk_bf16(float lo, float hi) { f32x2c_t v = {lo, hi}; bf16x2c_t b = __builtin_convertvector(v, bf16x2c_t); return __builtin_bit_cast(unsigned, b); }
typedef float f32x2 __attribute__((ext_vector_type(2)));
template <class Epi, class Sched, bool ALIGN_EPI = false, bool SP2 = false>
__device__ __forceinline__ void gemm_phase(PG8_LAS unsigned char* lds, const Gemm g, const Sched& S, const Epi& E) {
    int tid_ = threadIdx.x; asm volatile("" : "+v"(tid_));
    const int tid = tid_, wid = __builtin_amdgcn_readfirstlane(tid >> 6), lane = tid & 63, wr = wid >> 2, wc = wid & 3, fr = lane & 15, fq = lane >> 4;
    const int K = g.K, nt = K / BK;
    unsigned voffA[2], voffB[2];
#pragma unroll
    for (int i = 0; i < 2; ++i) { int R, C; stage_rc(tid * 16 + i * 8192, R, C); const int Rb = Epi::PERM ? ((R & ~31) + perm32(R & 31)) : R;
        voffA[i] = (unsigned)(R * K + C) * 2u; voffB[i] = (unsigned)(Rb * K + C) * 2u; }
    const size_t kstep = (size_t)(BK * 2);
    const size_t hstep = (size_t)HALF * K * 2;
    const size_t tstep = 2 * hstep;
    const unsigned ldsw = (unsigned)wid * 1024u;
    const int aoff = lds_byte(wr * 64 + fr, fq * 8), boff = lds_byte(wc * 32 + fr, fq * 8);
#define PG8_SA(b, h) (((b) * 2 + (h)) * HTB)
#define PG8_SB(b, h) ((4 + (b) * 2 + (h)) * HTB)
#define PG8_STAGE(bufoff, gbase, voff) do { _Pragma("unroll") for (int _i = 0; _i < 2; ++_i) \
        __builtin_amdgcn_global_load_lds((const unsigned*)((const char*)(gbase) + (voff)[_i]), (PG8_LAS unsigned*)(lds + (bufoff) + ldsw + _i * 8192), 16, 0, 0); } while (0)
#define PG8_LDA(dst, b, h) do { _Pragma("unroll") for (int m = 0; m < 4; ++m) _Pragma("unroll") for (int k = 0; k < 2; ++k) dst[m][k] = *(const PG8_LAS bf16x8*)(lds + PG8_SA(b, h) + aoff + m * 2048 + k * 1024); } while (0)
#define PG8_LDB(dst, b, h) do { _Pragma("unroll") for (int n = 0; n < 2; ++n) _Pragma("unroll") for (int k = 0; k < 2; ++k) dst[n][k] = *(const PG8_LAS bf16x8*)(lds + PG8_SB(b, h) + boff + n * 2048 + k * 1024); } while (0)
#define PG8_MMA(ai, bj, At, Bt) do { __builtin_amdgcn_s_setprio(1); _Pragma("unroll") for (int m = 0; m < 4; ++m) _Pragma("unroll") for (int n = 0; n < 2; ++n) _Pragma("unroll") for (int k = 0; k < 2; ++k) \
        acc[ai][bj][m][n] = __builtin_amdgcn_mfma_f32_16x16x32_bf16(Bt[n][k], At[m][k], acc[ai][bj][m][n], 0, 0, 0); __builtin_amdgcn_s_setprio(0); } while (0)
#define PG8_WAIT_V(n) asm volatile("s_waitcnt vmcnt(" #n ")" ::: "memory")
#define PG8_WAIT_L(n) asm volatile("s_waitcnt lgkmcnt(" #n ")" ::: "memory")
#define PG8_BAR __builtin_amdgcn_s_barrier()
#define PG8_SCHED __builtin_amdgcn_sched_barrier(0)
    Unit cur, nxt; int ui = 0;
    if (!S.next(0, cur)) return;
    f32x4 acc[2][2][4][2];
#pragma unroll
    for (int a = 0; a < 2; ++a)
#pragma unroll
        for (int b = 0; b < 2; ++b)
#pragma unroll
            for (int m = 0; m < 4; ++m)
#pragma unroll
                for (int n = 0; n < 2; ++n) acc[a][b][m][n] = (f32x4){0.f, 0.f, 0.f, 0.f};
    bf16x8 At[4][2], B0[2][2], B1[2][2];
    const char* cA = (const char*)g.A + (size_t)cur.pm * tstep; const char* cB = (const char*)g.Bt + (size_t)cur.pn * tstep;
    S.a_ready(cur);
    if constexpr (SP2) {
        PG8_STAGE(PG8_SB(0, 0), cB, voffB); PG8_STAGE(PG8_SB(0, 1), cB + hstep, voffB); PG8_STAGE(PG8_SA(0, 0), cA, voffA); PG8_STAGE(PG8_SA(0, 1), cA + hstep, voffA);
        if (wr == 1) PG8_BAR;
        PG8_WAIT_V(2); PG8_BAR;
        PG8_STAGE(PG8_SB(1, 0), cB + kstep, voffB); PG8_STAGE(PG8_SA(1, 0), cA + kstep, voffA); PG8_STAGE(PG8_SB(1, 1), cB + hstep + kstep, voffB);
        PG8_WAIT_V(6); PG8_BAR;
    } else {
        PG8_STAGE(PG8_SB(0, 0), cB, voffB); PG8_STAGE(PG8_SA(0, 0), cA, voffA); PG8_STAGE(PG8_SB(0, 1), cB + hstep, voffB); PG8_STAGE(PG8_SA(0, 1), cA + hstep, voffA);
        if (wr == 1) PG8_BAR;
        PG8_WAIT_V(4); PG8_BAR;
        PG8_STAGE(PG8_SB(1, 0), cB + kstep, voffB); PG8_STAGE(PG8_SA(1, 0), cA + kstep, voffA); PG8_STAGE(PG8_SB(1, 1), cB + hstep + kstep, voffB);
        PG8_WAIT_V(6); PG8_BAR;
    }
    for (;;) {
        const bool has_next = S.next(ui + 1, nxt);
        const char* nA = has_next ? (const char*)g.A + (size_t)nxt.pm * tstep : cA; const char* nB = has_next ? (const char*)g.Bt + (size_t)nxt.pn * tstep : cB;
        for (int t = 0; t < nt; t += 2) {
            const bool last = (t == nt - 2);
            const char* a1 = cA + (size_t)(t + 1) * kstep;
            const char* a2 = last ? nA : cA + (size_t)(t + 2) * kstep; const char* b2 = last ? nB : cB + (size_t)(t + 2) * kstep;
            const char* a3 = a2 + kstep; const char* b3 = b2 + kstep;
            if (last && has_next) S.a_ready(nxt);
            if constexpr (SP2) {
            PG8_LDB(B0, 0, 0); PG8_LDB(B1, 0, 1); PG8_SCHED; PG8_LDA(At, 0, 0); PG8_STAGE(PG8_SA(1, 1), a1 + hstep, voffA);
            PG8_WAIT_V(8); PG8_WAIT_L(0); PG8_BAR; PG8_MMA(0, 0, At, B0); PG8_MMA(0, 1, At, B1); PG8_BAR; PG8_SCHED;
            PG8_LDA(At, 0, 1); PG8_STAGE(PG8_SB(0, 0), b2, voffB); PG8_STAGE(PG8_SB(0, 1), b2 + hstep, voffB); PG8_STAGE(PG8_SA(0, 0), a2, voffA);
            PG8_WAIT_V(8); PG8_WAIT_L(0); PG8_BAR; PG8_MMA(1, 0, At, B0); PG8_MMA(1, 1, At, B1); PG8_BAR; PG8_SCHED;
            PG8_LDB(B0, 1, 0); PG8_LDB(B1, 1, 1); PG8_SCHED; PG8_LDA(At, 1, 0); PG8_STAGE(PG8_SA(0, 1), a2 + hstep, voffA);
            PG8_WAIT_V(8); PG8_WAIT_L(0); PG8_BAR; PG8_MMA(0, 0, At, B0); PG8_MMA(0, 1, At, B1); PG8_BAR; PG8_SCHED;
            PG8_LDA(At, 1, 1); PG8_STAGE(PG8_SB(1, 0), b3, voffB); PG8_STAGE(PG8_SB(1, 1), b3 + hstep, voffB); PG8_STAGE(PG8_SA(1, 0), a3, voffA);
            PG8_WAIT_V(8); PG8_WAIT_L(0); PG8_BAR; PG8_MMA(1, 0, At, B0); PG8_MMA(1, 1, At, B1); PG8_BAR; PG8_SCHED;
            } else {
            PG8_LDB(B0, 0, 0); PG8_SCHED; PG8_LDA(At, 0, 0); PG8_STAGE(PG8_SA(1, 1), a1 + hstep, voffA);
            PG8_WAIT_L(8); PG8_BAR; PG8_WAIT_L(0); PG8_MMA(0, 0, At, B0); PG8_BAR; PG8_SCHED;
            PG8_LDB(B1, 0, 1); PG8_STAGE(PG8_SB(0, 0), b2, voffB);
            PG8_BAR; PG8_WAIT_L(0); PG8_MMA(0, 1, At, B1); PG8_BAR;
            PG8_LDA(At, 0, 1); PG8_STAGE(PG8_SA(0, 0), a2, voffA);
            PG8_BAR; PG8_WAIT_L(0); PG8_MMA(1, 0, At, B0); PG8_BAR; PG8_SCHED;
            PG8_STAGE(PG8_SB(0, 1), b2 + hstep, voffB);
            PG8_WAIT_V(6); PG8_BAR; PG8_MMA(1, 1, At, B1); PG8_BAR;
            PG8_LDB(B0, 1, 0); PG8_SCHED; PG8_LDA(At, 1, 0); PG8_STAGE(PG8_SA(0, 1), a2 + hstep, voffA);
            PG8_WAIT_L(8); PG8_BAR; PG8_WAIT_L(0); PG8_MMA(0, 0, At, B0); PG8_BAR; PG8_SCHED;
            PG8_LDB(B1, 1, 1); PG8_STAGE(PG8_SB(1, 0), b3, voffB);
            PG8_BAR; PG8_WAIT_L(0); PG8_MMA(0, 1, At, B1); PG8_BAR;
            PG8_LDA(At, 1, 1); PG8_STAGE(PG8_SA(1, 0), a3, voffA);
            PG8_BAR; PG8_WAIT_L(0); PG8_MMA(1, 0, At, B0); PG8_BAR; PG8_SCHED;
            PG8_STAGE(PG8_SB(1, 1), b3 + hstep, voffB);
            PG8_WAIT_V(6); PG8_BAR; PG8_MMA(1, 1, At, B1); PG8_BAR;
            }
        }
        if constexpr (ALIGN_EPI) { if (wr == 0) PG8_BAR; }
        if constexpr (!Epi::AFTER_DRAIN) { E(acc, cur, wr, wc, fr, fq); S.done(cur); }
        if (!has_next) break;
#pragma unroll
        for (int a = 0; a < 2; ++a)
#pragma unroll
            for (int b = 0; b < 2; ++b)
#pragma unroll
                for (int m = 0; m < 4; ++m)
#pragma unroll
                    for (int n = 0; n < 2; ++n) acc[a][b][m][n] = (f32x4){0.f, 0.f, 0.f, 0.f};
        cur = nxt; cA = nA; cB = nB; ++ui;
        if constexpr (ALIGN_EPI) { if (wr == 1) PG8_BAR; }
    }
    PG8_WAIT_V(0);
    if constexpr (!ALIGN_EPI) { if (wr == 0) PG8_BAR; }
    PG8_BAR;
    if constexpr (Epi::AFTER_DRAIN) { E.fused(acc, cur, wr, wc, fr, fq, lds, wid, lane); S.done(cur); }
#undef PG8_SA
#undef PG8_SB
#undef PG8_STAGE
#undef PG8_LDA
#undef PG8_LDB
#undef PG8_MMA
#undef PG8_WAIT_V
#undef PG8_WAIT_L
#undef PG8_BAR
#undef PG8_SCHED
}
}
constexpr int M_TOK = 16384, SEQ = 8192, DM = 1024, DFF = 2816, NUP = 5632;
constexpr float RMS_EPS = 1e-6f;
constexpr float QC2 = 0.18033688011112042f;
constexpr size_t MiB = 1u << 20;
constexpr size_t WS_WIN = 0;
constexpr size_t WS_WA = 10 * MiB;
constexpr size_t WS_WB = 11 * MiB;
constexpr size_t WS_WOUT = 12 * MiB;
constexpr size_t WS_WUP = 14 * MiB;
constexpr size_t WS_WDN = 25 * MiB;
constexpr size_t WS_CS = 31 * MiB;
constexpr size_t WS_KMP = 33 * MiB;
constexpr size_t WS_SSQ = 34 * MiB;
constexpr size_t WS_HALO = 35 * MiB;
constexpr size_t WS_RAW = 38 * MiB;
constexpr size_t WS_XN = 41 * MiB;
constexpr size_t WS_QA = 73 * MiB;
constexpr size_t WS_KA = 89 * MiB;
constexpr size_t WS_QB = 105 * MiB;
constexpr size_t WS_KB = 121 * MiB;
constexpr int VT_PITCH = 16384 + 64;
constexpr size_t WS_VT = 137 * MiB;
constexpr size_t WS_G = 170 * MiB;
constexpr size_t WS_YA = 234 * MiB;
constexpr size_t WS_YB = 41 * MiB;
constexpr size_t WS_MRG = 57 * MiB;
constexpr size_t WS_X1B = 89 * MiB;
constexpr size_t WS_ACT = 121 * MiB;
constexpr size_t WS_END = 250 * MiB;

namespace pg8 {
__device__ __forceinline__ float sigmoidf_(float v) { return __builtin_amdgcn_rcpf(1.0f + __expf(-v)); }
typedef unsigned u32x2 __attribute__((ext_vector_type(2)));

struct EpiPlain {
    static constexpr bool PERM = true, AFTER_DRAIN = false;
    bf16_t* O; int ldc; float scale;
    __device__ __forceinline__ void operator()(f32x4 (&acc)[2][2][4][2], const Unit& u, int wr, int wc, int fr, int fq) const {
        const int row0 = u.pm * BM + wr * 64 + fr, col0 = u.pn * BM + wc * 32 + 8 * fq;
#pragma unroll
        for (int ai = 0; ai < 2; ++ai)
#pragma unroll
            for (int m = 0; m < 4; ++m) { bf16_t* rowp = O + (size_t)(row0 + ai * HALF + m * 16) * ldc + col0;
#pragma unroll
                for (int bj = 0; bj < 2; ++bj) { const f32x4 v0 = acc[ai][bj][m][0] * scale, v1 = acc[ai][bj][m][1] * scale;
                    u32x4 w; w.x = cvt_pk_bf16(v0[0], v0[1]); w.y = cvt_pk_bf16(v0[2], v0[3]); w.z = cvt_pk_bf16(v1[0], v1[1]); w.w = cvt_pk_bf16(v1[2], v1[3]);
                    *(u32x4*)(rowp + bj * HALF) = w; } }
    }
};

struct EpiInProj {
    static constexpr bool PERM = true, AFTER_DRAIN = false;
    bf16_t *QA, *KA, *QB, *KB, *G; const float* bgate; const float* cs; float* kmp;
    __device__ __forceinline__ void operator()(f32x4 (&acc)[2][2][4][2], const Unit& u, int wr, int wc, int fr, int fq) const {
        const int row0 = u.pm * BM + wr * 64 + fr;
        if (u.pn < 4) {
            const bool isk = u.pn >= 2; bf16_t* O = isk ? KA : QA; const int pnl = u.pn & 1; const float sc = isk ? 1.0f : QC2;
            const int d0 = 16 * (wc & 1) + 4 * fq;
            f32x4 ks[2][2];
#pragma unroll
            for (int bj = 0; bj < 2; ++bj) { ks[bj][0] = (f32x4){0.f, 0.f, 0.f, 0.f}; ks[bj][1] = (f32x4){0.f, 0.f, 0.f, 0.f}; }
#pragma unroll
            for (int ai = 0; ai < 2; ++ai)
#pragma unroll
                for (int m = 0; m < 4; ++m) { const int row = row0 + ai * HALF + m * 16, pos = row & (SEQ - 1);
                    const f32x4 c = *(const f32x4*)(cs + (size_t)pos * 64 + d0), s = *(const f32x4*)(cs + (size_t)pos * 64 + 32 + d0);
#pragma unroll
                    for (int bj = 0; bj < 2; ++bj) { const f32x4 v0 = acc[ai][bj][m][0], v1 = acc[ai][bj][m][1];
                        f32x4 o1 = v0 * c - v1 * s, o2 = v1 * c + v0 * s;
                        ks[bj][0] += o1; ks[bj][1] += o2;
                        o1 = o1 * sc; o2 = o2 * sc;
                        const int head = 4 * pnl + 2 * bj + (wc >> 1);
                        bf16_t* p = O + ((size_t)((row >> 13) * 8 + head) * SEQ + pos) * 64 + d0;
                        u32x2 w1, w2; w1.x = cvt_pk_bf16(o1[0], o1[1]); w1.y = cvt_pk_bf16(o1[2], o1[3]); w2.x = cvt_pk_bf16(o2[0], o2[1]); w2.y = cvt_pk_bf16(o2[2], o2[3]);
                        *(u32x2*)p = w1; *(u32x2*)(p + 32) = w2; } }
            if (isk) {
#pragma unroll
                for (int bj = 0; bj < 2; ++bj)
#pragma unroll
                    for (int hh = 0; hh < 2; ++hh) { f32x4 v = ks[bj][hh];
#pragma unroll
                        for (int o = 1; o < 16; o <<= 1) { v[0] += __shfl_xor(v[0], o); v[1] += __shfl_xor(v[1], o); v[2] += __shfl_xor(v[2], o); v[3] += __shfl_xor(v[3], o); }
                        if (fr == 0) { const int head = 4 * pnl + 2 * bj + (wc >> 1); *(f32x4*)(kmp + (size_t)(u.pm * 2 + wr) * 512 + head * 64 + hh * 32 + d0) = v; } }
            }
        } else if (u.pn < 8) {
            const bool isk = u.pn >= 6; bf16_t* O = isk ? KB : QB; const float sc = isk ? 1.0f : 0.125f;
            const int hd0 = (u.pn & 1) * 4 + (wc >> 1), dd = (wc & 1) * 32 + 8 * fq;
#pragma unroll
            for (int ai = 0; ai < 2; ++ai)
#pragma unroll
                for (int m = 0; m < 4; ++m) { const int row = row0 + ai * HALF + m * 16, pos = row & (SEQ - 1);
#pragma unroll
                    for (int bj = 0; bj < 2; ++bj) { const f32x4 v0 = acc[ai][bj][m][0] * sc, v1 = acc[ai][bj][m][1] * sc;
                        u32x4 w; w.x = cvt_pk_bf16(v0[0], v0[1]); w.y = cvt_pk_bf16(v0[2], v0[3]); w.z = cvt_pk_bf16(v1[0], v1[1]); w.w = cvt_pk_bf16(v1[2], v1[3]);
                        *(u32x4*)(O + ((size_t)((row >> 13) * 8 + hd0 + 2 * bj) * SEQ + pos) * 64 + dd) = w; } }
        } else {
            const int col0 = (u.pn - 8) * BM + wc * 32 + 8 * fq;
            f32x4 bv[2][2];
#pragma unroll
            for (int bj = 0; bj < 2; ++bj)
#pragma unroll
                for (int n = 0; n < 2; ++n) bv[bj][n] = *(const f32x4*)(bgate + col0 + bj * HALF + 4 * n);
#pragma unroll
            for (int ai = 0; ai < 2; ++ai)
#pragma unroll
                for (int m = 0; m < 4; ++m) { bf16_t* rowp = G + (size_t)(row0 + ai * HALF + m * 16) * 2048 + col0;
#pragma unroll
                    for (int bj = 0; bj < 2; ++bj) { f32x4 v0 = acc[ai][bj][m][0] + bv[bj][0], v1 = acc[ai][bj][m][1] + bv[bj][1];
#pragma unroll
                        for (int e = 0; e < 4; ++e) { v0[e] = sigmoidf_(v0[e]); v1[e] = sigmoidf_(v1[e]); }
                        u32x4 w; w.x = cvt_pk_bf16(v0[0], v0[1]); w.y = cvt_pk_bf16(v0[2], v0[3]); w.z = cvt_pk_bf16(v1[0], v1[1]); w.w = cvt_pk_bf16(v1[2], v1[3]);
                        *(u32x4*)(rowp + bj * HALF) = w; } }
        }
    }
};

__device__ __forceinline__ float bf_lo(unsigned w) { return __uint_as_float(w << 16); }
__device__ __forceinline__ float bf_hi(unsigned w) { return __uint_as_float(w & 0xffff0000u); }

template <int MODE> struct EpiBranch {
    static constexpr bool PERM = true, AFTER_DRAIN = false;
    bf16_t* MRG; const bf16_t* G;
    __device__ __forceinline__ void operator()(f32x4 (&acc)[2][2][4][2], const Unit& u, int wr, int wc, int fr, int fq) const {
        const int row0 = u.pm * BM + wr * 64 + fr, col0 = u.pn * BM + wc * 32 + 8 * fq;
#pragma unroll
        for (int ai = 0; ai < 2; ++ai)
#pragma unroll
            for (int m = 0; m < 4; ++m) { const size_t row = (size_t)(row0 + ai * HALF + m * 16);
#pragma unroll
                for (int bj = 0; bj < 2; ++bj) { const int col = col0 + bj * HALF;
                    const u32x4 g = *(const u32x4*)(G + row * 2048 + MODE * 1024 + col);
                    f32x4 v0 = acc[ai][bj][m][0], v1 = acc[ai][bj][m][1];
                    v0[0] *= bf_lo(g.x); v0[1] *= bf_hi(g.x); v0[2] *= bf_lo(g.y); v0[3] *= bf_hi(g.y);
                    v1[0] *= bf_lo(g.z); v1[1] *= bf_hi(g.z); v1[2] *= bf_lo(g.w); v1[3] *= bf_hi(g.w);
                    if (MODE == 1) { const u32x4 t = *(const u32x4*)(MRG + row * 1024 + col);
                        v0[0] += bf_lo(t.x); v0[1] += bf_hi(t.x); v0[2] += bf_lo(t.y); v0[3] += bf_hi(t.y);
                        v1[0] += bf_lo(t.z); v1[1] += bf_hi(t.z); v1[2] += bf_lo(t.w); v1[3] += bf_hi(t.w); }
                    u32x4 w; w.x = cvt_pk_bf16(v0[0], v0[1]); w.y = cvt_pk_bf16(v0[2], v0[3]); w.z = cvt_pk_bf16(v1[0], v1[1]); w.w = cvt_pk_bf16(v1[2], v1[3]);
                    *(u32x4*)(MRG + row * 1024 + col) = w; } }
    }
};

template <bool WITH_B> struct EpiResid {
    static constexpr bool PERM = true, AFTER_DRAIN = false;
    const float* XIN; float* XOUT; bf16_t* XB; float* ssq;
    __device__ __forceinline__ void operator()(f32x4 (&acc)[2][2][4][2], const Unit& u, int wr, int wc, int fr, int fq) const {
        const int row0 = u.pm * BM + wr * 64 + fr, col0 = u.pn * BM + wc * 32 + 8 * fq;
#pragma unroll
        for (int ai = 0; ai < 2; ++ai)
#pragma unroll
            for (int m = 0; m < 4; ++m) { const size_t row = (size_t)(row0 + ai * HALF + m * 16); float sq = 0.f;
#pragma unroll
                for (int bj = 0; bj < 2; ++bj) { const size_t off = row * DM + col0 + bj * HALF;
                    const f32x4 v0 = acc[ai][bj][m][0] + *(const f32x4*)(XIN + off), v1 = acc[ai][bj][m][1] + *(const f32x4*)(XIN + off + 4);
                    *(f32x4*)(XOUT + off) = v0; *(f32x4*)(XOUT + off + 4) = v1;
                    if (WITH_B) { sq += (v0[0] * v0[0] + v0[1] * v0[1]) + (v0[2] * v0[2] + v0[3] * v0[3]) + (v1[0] * v1[0] + v1[1] * v1[1]) + (v1[2] * v1[2] + v1[3] * v1[3]);
                        u32x4 w; w.x = cvt_pk_bf16(v0[0], v0[1]); w.y = cvt_pk_bf16(v0[2], v0[3]); w.z = cvt_pk_bf16(v1[0], v1[1]); w.w = cvt_pk_bf16(v1[2], v1[3]);
                        *(u32x4*)(XB + off) = w; } }
                if (WITH_B) { sq += __shfl_xor(sq, 16); sq += __shfl_xor(sq, 32); if (fq == 0) ssq[row * 16 + u.pn * 4 + wc] = sq; } }
    }
};

#define DPP_F(old_, src_, ctrl_) __uint_as_float((unsigned)__builtin_amdgcn_update_dpp((int)__float_as_uint(old_), (int)__float_as_uint(src_), ctrl_, 0xf, 0xf, false))
struct EpiUp {
    static constexpr bool PERM = true, AFTER_DRAIN = false;
    bf16_t* ACT; const float* ssq; const float* cw; const float* cb; float* halo; float* raw; PG8_LAS float* xl;
    __device__ __forceinline__ void operator()(f32x4 (&acc)[2][2][4][2], const Unit& u, int wr, int wc, int fr, int fq) const {
        const int row0 = u.pm * BM + wr * 64 + fr, tcol = wc * 32 + 8 * fq;
#pragma unroll
        for (int ai = 0; ai < 2; ++ai)
#pragma unroll
            for (int m = 0; m < 4; ++m) { const f32x4 p = *(const f32x4*)(ssq + (size_t)(row0 + ai * HALF + m * 16) * 16 + 4 * fq);
                float s = (p[0] + p[1]) + (p[2] + p[3]); s += __shfl_xor(s, 16); s += __shfl_xor(s, 32);
                const float rs = __builtin_amdgcn_rsqf(s * (1.0f / DM) + RMS_EPS);
#pragma unroll
                for (int bj = 0; bj < 2; ++bj) { acc[ai][bj][m][0] = acc[ai][bj][m][0] * rs; acc[ai][bj][m][1] = acc[ai][bj][m][1] * rs; } }
        if (fr >= 14) {
#pragma unroll
            for (int ai = 0; ai < 2; ++ai)
#pragma unroll
                for (int bj = 0; bj < 2; ++bj)
#pragma unroll
                    for (int n = 0; n < 2; ++n) { *(PG8_LAS f32x4*)(xl + ((ai * 2 + wr) * 2 + (fr - 14)) * 256 + bj * HALF + tcol + 4 * n) = acc[ai][bj][3][n];
                        if (ai == 1 && wr == 1) *(f32x4*)(halo + (size_t)(u.pm * 2 + (fr - 14)) * NUP + u.pn * BM + bj * HALF + tcol + 4 * n) = acc[1][bj][3][n]; }
        }
        if (fr < 2 && wr == 0) {
#pragma unroll
            for (int bj = 0; bj < 2; ++bj)
#pragma unroll
                for (int n = 0; n < 2; ++n) *(f32x4*)(raw + (size_t)(u.pm * 2 + fr) * NUP + u.pn * BM + bj * HALF + tcol + 4 * n) = acc[0][bj][0][n];
        }
        asm volatile("s_waitcnt lgkmcnt(0)" ::: "memory"); __builtin_amdgcn_s_barrier(); asm volatile("" ::: "memory");
        const int ch = u.pn * HALF + tcol;
#pragma unroll
        for (int n = 0; n < 2; ++n) {
            f32x4 w0[2], w1[2], w2[2], bb[2];
#pragma unroll
            for (int bj = 0; bj < 2; ++bj) { const int c = bj * DFF + ch + 4 * n;
                w0[bj] = *(const f32x4*)(cw + c); w1[bj] = *(const f32x4*)(cw + NUP + c); w2[bj] = *(const f32x4*)(cw + 2 * NUP + c); bb[bj] = *(const f32x4*)(cb + c); }
#pragma unroll
            for (int ai = 0; ai < 2; ++ai) {
                f32x4 hv[2];
                const int src = ai * 2 + wr - 1;
#pragma unroll
                for (int bj = 0; bj < 2; ++bj) { hv[bj] = (f32x4){0.f, 0.f, 0.f, 0.f};
                    if (fr >= 14 && src >= 0) hv[bj] = *(const PG8_LAS f32x4*)(xl + (src * 2 + (fr - 14)) * 256 + bj * HALF + tcol + 4 * n); }
#pragma unroll
                for (int m = 0; m < 4; ++m) { f32x4 cv[2];
#pragma unroll
                    for (int bj = 0; bj < 2; ++bj) { const f32x4 cur = acc[ai][bj][m][n]; const f32x4 prv = (m == 0) ? hv[bj] : acc[ai][bj][m == 0 ? 0 : m - 1][n];
#pragma unroll
                        for (int e = 0; e < 4; ++e) {
                            const float r1 = DPP_F(0.f, prv[e], 0x121), r2 = DPP_F(0.f, prv[e], 0x122);
                            const float p1 = DPP_F(r1, cur[e], 0x111), p2 = DPP_F(r2, cur[e], 0x112);
                            cv[bj][e] = (w0[bj][e] * p2 + w1[bj][e] * p1) + (w2[bj][e] * cur[e] + bb[bj][e]); } }
                    float a[4];
#pragma unroll
                    for (int e = 0; e < 4; ++e) { const float g = cv[0][e]; a[e] = g * sigmoidf_(g) * cv[1][e]; }
                    const bool skip = (ai == 0 && m == 0 && wr == 0 && fr < 2);
                    u32x2 w; w.x = cvt_pk_bf16(a[0], a[1]); w.y = cvt_pk_bf16(a[2], a[3]);
                    if (!skip) *(u32x2*)(ACT + (size_t)(row0 + ai * HALF + m * 16) * DFF + ch + 4 * n) = w; }
            }
        }
    }
};
}
namespace att {
typedef unsigned short bf16_t;
typedef short bf16x8 __attribute__((ext_vector_type(8)));
typedef float f32x4 __attribute__((ext_vector_type(4)));
typedef unsigned u32x4 __attribute__((ext_vector_type(4)));
typedef unsigned u32x2 __attribute__((ext_vector_type(2)));
#define ATT_LAS __attribute__((address_space(3)))
__device__ __forceinline__ f32x4 mfma16(bf16x8 a, bf16x8 b, f32x4 c) { return __builtin_amdgcn_mfma_f32_16x16x32_bf16(a, b, c, 0, 0, 0); }
typedef float f32x2c_t __attribute__((ext_vector_type(2))); typedef __bf16 bf16x2c_t __attribute__((ext_vector_type(2)));
__device__ __forceinline__ unsigned cvtpk(float lo, float hi) { f32x2c_t v = {lo, hi}; bf16x2c_t b = __builtin_convertvector(v, bf16x2c_t); return __builtin_bit_cast(unsigned, b); }
__device__ __forceinline__ int keyperm(int kk, int m) { return 32 * (kk >> 1) + 8 * (m >> 2) + 4 * (kk & 1) + (m & 3); }
__device__ __forceinline__ bf16x8 pack8(const f32x4& a, const f32x4& b) { u32x4 w; w.x = cvtpk(a[0], a[1]); w.y = cvtpk(a[2], a[3]); w.z = cvtpk(b[0], b[1]); w.w = cvtpk(b[2], b[3]); return __builtin_bit_cast(bf16x8, w); }

__device__ __forceinline__ void sb_unit(const bf16_t* QB, const bf16_t* KB, const bf16_t* VT, bf16_t* YB, int b, int h, int qg, int lane) {
    const int fr = lane & 15, fq = lane >> 4;
    const int t = qg * 16 + fr;
    const size_t rb = (size_t)b * SEQ, hb = (size_t)(b * 8 + h) * SEQ;
    const bf16_t* qp = QB + (hb + t) * 64 + 8 * fq;
    const bf16x8 q0 = *(const bf16x8*)qp, q1 = *(const bf16x8*)(qp + 32);
    f32x4 o[4];
#pragma unroll
    for (int d = 0; d < 4; ++d) o[d] = (f32x4){0.f, 0.f, 0.f, 0.f};
    float carry = 0.f;
    const bf16_t* vbase = VT + (size_t)(512 + h * 64 + fr) * VT_PITCH + rb + 8 * fq;
    const int kt0 = (qg * 16 + 15) >> 6;
    bf16x8 kf[8];
#pragma unroll
    for (int kk = 0; kk < 4; ++kk) { const bf16_t* kp = KB + (hb + kt0 * 64 + keyperm(kk, fr)) * 64 + 8 * fq; kf[2 * kk] = *(const bf16x8*)kp; kf[2 * kk + 1] = *(const bf16x8*)(kp + 32); }
    for (int kt = kt0; kt >= 0; --kt) {
        const int k0 = kt * 64;
        bf16x8 vf[8];
#pragma unroll
        for (int dt = 0; dt < 4; ++dt) { const bf16_t* vp = vbase + (size_t)(16 * dt) * VT_PITCH + k0; vf[2 * dt] = *(const bf16x8*)vp; vf[2 * dt + 1] = *(const bf16x8*)(vp + 32); }
        f32x4 s[4];
#pragma unroll
        for (int kk = 0; kk < 4; ++kk) { s[kk] = mfma16(kf[2 * kk], q0, (f32x4){0.f, 0.f, 0.f, 0.f}); s[kk] = mfma16(kf[2 * kk + 1], q1, s[kk]); }
        if (kt > 0) {
#pragma unroll
            for (int kk = 0; kk < 4; ++kk) { const bf16_t* kp = KB + (hb + k0 - 64 + keyperm(kk, fr)) * 64 + 8 * fq; kf[2 * kk] = *(const bf16x8*)kp; kf[2 * kk + 1] = *(const bf16x8*)(kp + 32); }
        }
        float lm[4][4], ls[4][4];
#pragma unroll
        for (int kk = 0; kk < 4; ++kk)
#pragma unroll
            for (int e = 0; e < 4; ++e) { const int key = k0 + 32 * (kk >> 1) + 8 * fq + 4 * (kk & 1) + e; const float z = s[kk][e];
                const float sp = fmaxf(z, 0.f) + __logf(1.0f + __expf(-fabsf(z)));
                const bool ok = key < t; lm[kk][e] = ok ? -sp : 0.f; ls[kk][e] = ok ? (z - sp) : -INFINITY; }
        float tl = 0.f, th = 0.f;
#pragma unroll
        for (int e = 0; e < 4; ++e) { tl += lm[0][e]; th += lm[2][e]; }
#pragma unroll
        for (int e = 0; e < 4; ++e) { tl += lm[1][e]; th += lm[3][e]; }
        float tlj[4], thj[4];
#pragma unroll
        for (int j = 0; j < 4; ++j) { tlj[j] = __shfl(tl, fr + 16 * j); thj[j] = __shfl(th, fr + 16 * j); }
        const float TH = (thj[0] + thj[1]) + (thj[2] + thj[3]), TL = (tlj[0] + tlj[1]) + (tlj[2] + tlj[3]);
        float ah = carry, al = carry + TH;
#pragma unroll
        for (int j = 3; j >= 1; --j) { if (fq < j) { ah += thj[j]; al += tlj[j]; } }
        f32x4 a[4];
        float run = ah;
#pragma unroll
        for (int kk = 3; kk >= 2; --kk)
#pragma unroll
            for (int e = 3; e >= 0; --e) { a[kk][e] = __expf(ls[kk][e] + run); run += lm[kk][e]; }
        run = al;
#pragma unroll
        for (int kk = 1; kk >= 0; --kk)
#pragma unroll
            for (int e = 3; e >= 0; --e) { a[kk][e] = __expf(ls[kk][e] + run); run += lm[kk][e]; }
        carry += TH + TL;
        const bf16x8 p0 = pack8(a[0], a[1]), p1 = pack8(a[2], a[3]);
#pragma unroll
        for (int dt = 0; dt < 4; ++dt) { o[dt] = mfma16(vf[2 * dt], p0, o[dt]); o[dt] = mfma16(vf[2 * dt + 1], p1, o[dt]); }
        if (__all(carry < -110.0f)) break;
    }
    bf16_t* yp = YB + (rb + t) * 512 + h * 64 + 4 * fq;
#pragma unroll
    for (int dt = 0; dt < 4; ++dt) { u32x2 w; w.x = cvtpk(o[dt][0], o[dt][1]); w.y = cvtpk(o[dt][2], o[dt][3]); *(u32x2*)(yp + 16 * dt) = w; }
}

__device__ __forceinline__ void moba_item(const bf16_t* QA, const bf16_t* KA, const bf16_t* VT, size_t rb, int h, int i, int j, int qidx, bool causal, int qmax, bool first,
                                          ATT_LAS float* st_m, ATT_LAS float* st_l, ATT_LAS float* st_o, int lane) {
    const int fr = lane & 15, fq = lane >> 4;
    const bool valid = qidx >= 0; const int q = valid ? qidx : 0;
    const size_t hb = (size_t)((int)(rb >> 13) * 8 + h) * SEQ;
    const bf16_t* qp = QA + (hb + 256 * i + q) * 64 + 8 * fq;
    const bf16x8 q0 = *(const bf16x8*)qp, q1 = *(const bf16x8*)(qp + 32);
    const bf16_t* kb = KA + (hb + 256 * j) * 64 + 8 * fq;
    f32x4 s[16];
    {
        bf16x8 kf[2][8];
#pragma unroll
        for (int t = 0; t < 4; ++t) { const bf16_t* kp = kb + (size_t)keyperm(t, fr) * 64; kf[0][2 * t] = *(const bf16x8*)kp; kf[0][2 * t + 1] = *(const bf16x8*)(kp + 32); }
#pragma unroll
        for (int g = 0; g < 4; ++g) {
            if (g < 3) {
#pragma unroll
                for (int t = 0; t < 4; ++t) { const bf16_t* kp = kb + (size_t)keyperm(4 * (g + 1) + t, fr) * 64; kf[(g + 1) & 1][2 * t] = *(const bf16x8*)kp; kf[(g + 1) & 1][2 * t + 1] = *(const bf16x8*)(kp + 32); }
            }
#pragma unroll
            for (int t = 0; t < 4; ++t) { s[4 * g + t] = mfma16(kf[g & 1][2 * t], q0, (f32x4){0.f, 0.f, 0.f, 0.f}); s[4 * g + t] = mfma16(kf[g & 1][2 * t + 1], q1, s[4 * g + t]); }
        }
    }
    if (causal) {
#pragma unroll
        for (int kk = 0; kk < 16; ++kk)
#pragma unroll
            for (int e = 0; e < 4; ++e) { const int key = 32 * (kk >> 1) + 8 * fq + 4 * (kk & 1) + e; if (key > q) s[kk][e] = -INFINITY; }
    }
    float mb = -INFINITY;
#pragma unroll
    for (int kk = 0; kk < 16; ++kk) mb = fmaxf(mb, fmaxf(fmaxf(s[kk][0], s[kk][1]), fmaxf(s[kk][2], s[kk][3])));
    mb = fmaxf(mb, __shfl_xor(mb, 16)); mb = fmaxf(mb, __shfl_xor(mb, 32));
    float lb = 0.f;
#pragma unroll
    for (int kk = 0; kk < 16; ++kk)
#pragma unroll
        for (int e = 0; e < 4; ++e) { const float p = __builtin_amdgcn_exp2f(s[kk][e] - mb); s[kk][e] = p; lb += p; }
    lb += __shfl_xor(lb, 16); lb += __shfl_xor(lb, 32);
    f32x4 o[4];
#pragma unroll
    for (int d = 0; d < 4; ++d) o[d] = (f32x4){0.f, 0.f, 0.f, 0.f};
    const bf16_t* vb = VT + (size_t)(h * 64 + fr) * VT_PITCH + rb + 256 * j + 8 * fq;
    (void)qmax;
    {
        bf16x8 vf[2][8];
#pragma unroll
        for (int t = 0; t < 8; ++t) vf[0][t] = *(const bf16x8*)(vb + (size_t)(16 * (t & 3)) * VT_PITCH + 32 * (t >> 2));
#pragma unroll
        for (int g = 0; g < 4; ++g) {
            if (g < 3) {
#pragma unroll
                for (int t = 0; t < 8; ++t) vf[(g + 1) & 1][t] = *(const bf16x8*)(vb + (size_t)(16 * (t & 3)) * VT_PITCH + 32 * (2 * (g + 1) + (t >> 2)));
            }
#pragma unroll
            for (int hh = 0; hh < 2; ++hh) { const int ks = 2 * g + hh; const bf16x8 p = pack8(s[2 * ks], s[2 * ks + 1]);
#pragma unroll
                for (int dt = 0; dt < 4; ++dt) o[dt] = mfma16(vf[g & 1][4 * hh + dt], p, o[dt]); }
        }
    }
    if (valid) {
        ATT_LAS float* so = st_o + q * 68 + 4 * fq;
        if (first) {
            if (fq == 0) { st_m[q] = mb; st_l[q] = lb; }
#pragma unroll
            for (int dt = 0; dt < 4; ++dt) *(ATT_LAS f32x4*)(so + 16 * dt) = o[dt];
        } else {
            const float mo = st_m[q], lo = st_l[q]; const float mn = fmaxf(mo, mb);
            const float ca = __builtin_amdgcn_exp2f(mo - mn), cb2 = __builtin_amdgcn_exp2f(mb - mn);
            f32x4 oo[4];
#pragma unroll
            for (int dt = 0; dt < 4; ++dt) oo[dt] = *(const ATT_LAS f32x4*)(so + 16 * dt);
#pragma unroll
            for (int dt = 0; dt < 4; ++dt) *(ATT_LAS f32x4*)(so + 16 * dt) = oo[dt] * ca + o[dt] * cb2;
            if (fq == 0) { st_m[q] = mn; st_l[q] = lo * ca + lb * cb2; }
        }
    }
}

constexpr int L_KM = 0;
constexpr int L_CAND = 8192;
constexpr int L_SEL = 20480;
constexpr int L_CNT = 23552;
constexpr int L_LIST = 24576;
constexpr int L_STM = 49152;
constexpr int L_STL = 50176;
constexpr int L_STO = 51200;

__device__ __forceinline__ void wg_bar() { asm volatile("s_waitcnt vmcnt(0) lgkmcnt(0)" ::: "memory"); __builtin_amdgcn_s_barrier(); asm volatile("" ::: "memory"); }

__device__ __forceinline__ void moba_unit(ATT_LAS unsigned char* lds, const bf16_t* QA, const bf16_t* KA, const bf16_t* VT, const float* KMP, bf16_t* YA, int b, int h, int i) {
    int tid_ = threadIdx.x; asm volatile("" : "+v"(tid_));
    const int tid = tid_, lane = tid & 63, wid = __builtin_amdgcn_readfirstlane(tid >> 6);
    ATT_LAS float* km = (ATT_LAS float*)(lds + L_KM);
    ATT_LAS float* candv = (ATT_LAS float*)(lds + L_CAND); ATT_LAS int* candi = (ATT_LAS int*)(lds + L_CAND + 6144);
    ATT_LAS int* sel = (ATT_LAS int*)(lds + L_SEL); ATT_LAS int* cnt = (ATT_LAS int*)(lds + L_CNT);
    ATT_LAS unsigned char* list = (ATT_LAS unsigned char*)(lds + L_LIST);
    ATT_LAS float* st_m = (ATT_LAS float*)(lds + L_STM); ATT_LAS float* st_l = (ATT_LAS float*)(lds + L_STL); ATT_LAS float* st_o = (ATT_LAS float*)(lds + L_STO);
    const size_t rb = (size_t)b * SEQ;
    wg_bar();
    for (int idx = tid; idx < i * 64; idx += 512) { const int j = idx >> 6, d = idx & 63; const float* p = KMP + (size_t)((b * 32 + j) * 2) * 512 + h * 64 + d; km[idx] = (p[0] + p[512]) * (1.0f / 256.0f); }
    if (tid < 96) cnt[tid] = 0;
    wg_bar();
    {
        const int q = tid & 255, half = tid >> 8;
        const bf16_t* qp = QA + ((size_t)(b * 8 + h) * SEQ + 256 * i + q) * 64;
        float qf[64];
#pragma unroll
        for (int c = 0; c < 8; ++c) { const u32x4 w = *(const u32x4*)(qp + 8 * c);
            qf[8 * c + 0] = __uint_as_float(w.x << 16); qf[8 * c + 1] = __uint_as_float(w.x & 0xffff0000u); qf[8 * c + 2] = __uint_as_float(w.y << 16); qf[8 * c + 3] = __uint_as_float(w.y & 0xffff0000u);
            qf[8 * c + 4] = __uint_as_float(w.z << 16); qf[8 * c + 5] = __uint_as_float(w.z & 0xffff0000u); qf[8 * c + 6] = __uint_as_float(w.w << 16); qf[8 * c + 7] = __uint_as_float(w.w & 0xffff0000u); }
        float v0 = -INFINITY, v1 = -INFINITY, v2 = -INFINITY; int i0 = -1, i1 = -1, i2 = -1;
        const int jlo = 16 * half, jhi = (i < jlo + 16) ? i : jlo + 16;
        for (int j = jlo; j < jhi; ++j) {
            const ATT_LAS f32x4* kr = (const ATT_LAS f32x4*)(km + j * 64);
            float g0 = 0.f, g1 = 0.f, g2 = 0.f, g3 = 0.f;
#pragma unroll
            for (int c = 0; c < 16; ++c) { const f32x4 kv = kr[c]; g0 = fmaf(qf[4 * c], kv[0], g0); g1 = fmaf(qf[4 * c + 1], kv[1], g1); g2 = fmaf(qf[4 * c + 2], kv[2], g2); g3 = fmaf(qf[4 * c + 3], kv[3], g3); }
            const float g = (g0 + g1) + (g2 + g3);
            if (g > v0) { v2 = v1; i2 = i1; v1 = v0; i1 = i0; v0 = g; i0 = j; }
            else if (g > v1) { v2 = v1; i2 = i1; v1 = g; i1 = j; }
            else if (g > v2) { v2 = g; i2 = j; }
        }
        const int cb = (half * 256 + q) * 3;
        candv[cb] = v0; candv[cb + 1] = v1; candv[cb + 2] = v2; candi[cb] = i0; candi[cb + 1] = i1; candi[cb + 2] = i2;
    }
    wg_bar();
    if (tid < 256) {
        const int q = tid; float av[3], bv[3]; int ax[3], bx[3];
#pragma unroll
        for (int r = 0; r < 3; ++r) { av[r] = candv[q * 3 + r]; ax[r] = candi[q * 3 + r]; bv[r] = candv[(256 + q) * 3 + r]; bx[r] = candi[(256 + q) * 3 + r]; }
        int pa = 0, pb = 0;
#pragma unroll
        for (int r = 0; r < 3; ++r) {
            const float va = pa == 0 ? av[0] : pa == 1 ? av[1] : pa == 2 ? av[2] : -INFINITY; const int xa = pa == 0 ? ax[0] : pa == 1 ? ax[1] : pa == 2 ? ax[2] : -1;
            const float vb = pb == 0 ? bv[0] : pb == 1 ? bv[1] : pb == 2 ? bv[2] : -INFINITY; const int xb = pb == 0 ? bx[0] : pb == 1 ? bx[1] : pb == 2 ? bx[2] : -1;
            int pick;
            if (xa >= 0 && (xb < 0 || va >= vb)) { pick = xa; ++pa; } else if (xb >= 0) { pick = xb; ++pb; } else pick = -1;
            sel[q * 3 + r] = pick;
            if (pick >= 0) { const int slot = atomicAdd((int*)&cnt[r * 32 + pick], 1); list[(r * 32 + pick) * 256 + slot] = (unsigned char)q; }
        }
    }
    wg_bar();
    for (int ph = 0; ph < 4; ++ph) {
        int total, incl = 0, nl = 0;
        if (ph == 0) total = 16;
        else { if (lane < 32) nl = (cnt[(ph - 1) * 32 + lane] + 15) >> 4; incl = nl;
#pragma unroll
            for (int o = 1; o < 32; o <<= 1) { const int t = __shfl_up(incl, o); if ((lane & 31) >= o) incl += t; }
            total = __builtin_amdgcn_readfirstlane(__shfl(incl, 31)); }
        for (int k = wid; k < total; k += 8) {
            int j, qidx, qmax; bool causal;
            if (ph == 0) { j = i; qidx = 16 * k + (lane & 15); qmax = 16 * k + 15; causal = true; }
            else { const unsigned long long bm = __ballot(lane < 32 && incl > k); j = __builtin_amdgcn_readfirstlane((int)__builtin_ctzll(bm));
                const int excl = __builtin_amdgcn_readfirstlane(__shfl(incl - nl, j)); const int grp = k - excl; const int n = cnt[(ph - 1) * 32 + j];
                const int pos = grp * 16 + (lane & 15); qidx = pos < n ? (int)list[((ph - 1) * 32 + j) * 256 + pos] : -1; qmax = 255; causal = false; }
            moba_item(QA, KA, VT, rb, h, i, j, qidx, causal, qmax, ph == 0, st_m, st_l, st_o, lane);
        }
        wg_bar();
    }
    { const int q = tid >> 1, hf = tid & 1; const float rl = 1.0f / st_l[q]; const ATT_LAS float* so = st_o + q * 68 + 32 * hf;
      bf16_t* yp = YA + (rb + 256 * i + q) * 512 + h * 64 + 32 * hf;
#pragma unroll
      for (int c = 0; c < 4; ++c) { const f32x4 a = *(const ATT_LAS f32x4*)(so + 8 * c) * rl, bq = *(const ATT_LAS f32x4*)(so + 8 * c + 4) * rl;
          u32x4 w; w.x = cvtpk(a[0], a[1]); w.y = cvtpk(a[2], a[3]); w.z = cvtpk(bq[0], bq[1]); w.w = cvtpk(bq[2], bq[3]); *(u32x4*)(yp + 8 * c) = w; } }
}
}
#define LAS __attribute__((address_space(3)))
typedef unsigned short bf16;
typedef unsigned v4u __attribute__((ext_vector_type(4)));
typedef float f32x4 __attribute__((ext_vector_type(4)));
typedef __attribute__((address_space(1))) unsigned gu32;
constexpr int NWAVES = 8;
constexpr int RING_BYTES = 131072, EXCH_OFF = RING_BYTES, LDS_BYTES = 163840;
__device__ __forceinline__ unsigned f2bf(float f) { unsigned u = __builtin_bit_cast(unsigned, f); return (u + 0x7fffu + ((u >> 16) & 1u)) >> 16; }
__device__ __forceinline__ unsigned pk2(float lo, float hi) { return f2bf(lo) | (f2bf(hi) << 16); }
__device__ __forceinline__ float wave_sum(float v) {
#pragma unroll
    for (int o = 1; o < 64; o <<= 1) v += __shfl_xor(v, o);
    return v;
}
#define XB_TMO      128
#define XB_XCNT(j)  (256  + 64 * (j))
#define XB_XSUB(j)  (1280 + 64 * (j))
#define XB_XGEN(j)  (2304 + 64 * (j))
#define XB_TOP      3328
#define XB_TOPGEN   3392
#define XCD_BAR_WORDS 3456
#define XB_SPIN_CAP (1u << 18)

__device__ __forceinline__ unsigned xb_ld(unsigned* p)              { return __hip_atomic_load(p, __ATOMIC_RELAXED, __HIP_MEMORY_SCOPE_AGENT); }
__device__ __forceinline__ unsigned xb_add(unsigned* p, unsigned v) { return __hip_atomic_fetch_add(p, v, __ATOMIC_RELAXED, __HIP_MEMORY_SCOPE_AGENT); }
__device__ __forceinline__ unsigned xb_xcc_id() { return (unsigned)__builtin_amdgcn_s_getreg((3 << 11) | 20) & 0xFu; }
#define XB_SPIN(cond, bar) do { unsigned _sp = 0; while (cond) { __builtin_amdgcn_s_sleep(1); \
    if ((++_sp & 255u) == 0u) { if (xb_ld(&(bar)[XB_TMO])) break; if (_sp > XB_SPIN_CAP) { atomicAdd(&(bar)[XB_TMO], 1u); break; } } } } while (0)

struct XcdBarrier {
    unsigned* bar; unsigned x;
    volatile LAS unsigned* st;
};

__device__ __forceinline__ XcdBarrier xcd_barrier_post(unsigned* bar, volatile LAS unsigned* st) {
    XcdBarrier b; b.bar = bar; b.x = xb_xcc_id(); b.st = st;
    if (threadIdx.x == 0) (void)xb_add(&bar[XB_XCNT(b.x)], 1u);
    return b;
}
__device__ __forceinline__ void xcd_barrier_complete(unsigned* bar, unsigned x, unsigned& nloc, unsigned& nx) {
    const unsigned G = gridDim.x * gridDim.y * gridDim.z;
    unsigned sum, cnt, mine, sp = 0u;
    for (;;) {
        sum = 0u; cnt = 0u; mine = 0u;
#pragma unroll
        for (unsigned j = 0; j < 16; ++j) { const unsigned c = xb_ld(&bar[XB_XCNT(j)]); sum += c; cnt += (c > 0u) ? 1u : 0u; mine = (j == x) ? c : mine; }
        if (sum == G) break;
        __builtin_amdgcn_s_sleep(1);
        if ((++sp & 255u) == 0u) { if (xb_ld(&bar[XB_TMO])) break; if (sp > XB_SPIN_CAP) { atomicAdd(&bar[XB_TMO], 1u); break; } }
    }
    nloc = mine > 0u ? mine : 1u; nx = cnt > 0u ? cnt : 1u;
}

__device__ __forceinline__ void xcd_barrier(const XcdBarrier& b) {
    asm volatile("s_waitcnt vmcnt(0)" ::: "memory");
    __syncthreads();
    if (threadIdx.x == 0) {
        unsigned* bar = b.bar;
        __builtin_amdgcn_s_waitcnt(0);
        unsigned nloc = b.st[0], nx = b.st[1];
        if (nloc == 0u) { xcd_barrier_complete(bar, b.x, nloc, nx); b.st[0] = nloc; b.st[1] = nx; }
        const unsigned old = xb_add(&bar[XB_XSUB(b.x)], 1u);
        const unsigned gen = old / nloc;
        if (old + 1u == (gen + 1u) * nloc) {
            __builtin_amdgcn_fence(__ATOMIC_RELEASE, "agent");
            asm volatile("s_waitcnt vmcnt(0)" ::: "memory");
            const unsigned og = xb_add(&bar[XB_TOP], 1u);
            const unsigned tg = og / nx;
            if (og + 1u == (tg + 1u) * nx) xb_add(&bar[XB_TOPGEN], 1u);
            else XB_SPIN(xb_ld(&bar[XB_TOPGEN]) == tg, bar);
            __builtin_amdgcn_fence(__ATOMIC_ACQUIRE, "agent");
            xb_add(&bar[XB_XGEN(b.x)], 1u);
            asm volatile("s_waitcnt vmcnt(0)" ::: "memory");
        } else {
            XB_SPIN(xb_ld(&bar[XB_XGEN(b.x)]) == gen, bar);
            __builtin_amdgcn_fence(__ATOMIC_ACQUIRE, "agent");
            asm volatile("s_waitcnt vmcnt(0)" ::: "memory");
        }
    }
    __syncthreads();
}

constexpr size_t WS_CTL = 40 * MiB + 768 * 1024;
__device__ __forceinline__ int map_win(int c) {
    if (c < 1024) { const int reg = c >> 9, cc = c & 511, head = cc >> 6, d = cc & 63; const int pp = 8 * ((d >> 2) & 7) + 4 * (d >> 5) + (d & 3); return reg * 512 + head * 64 + pp; }
    if (c < 1536) return 4096 + (c - 1024);
    if (c < 2048) return 1024 + (c - 1536);
    if (c < 2560) return 1536 + (c - 2048);
    if (c < 3072) return 4608 + (c - 2560);
    return 2048 + (c - 3072);
}
__device__ __forceinline__ int map_wup(int c) { const int v = c >= DFF ? 1 : 0, cc = c - v * DFF; return 256 * (cc >> 7) + 128 * v + (cc & 127); }
template <int MAP> __device__ __forceinline__ void transpose_item(const float* W, int K, int N, bf16* WT, const float* kscale, LAS float* scr, int item, int lane) {
    const int nblk = N / 32, kb = item / nblk, nb = item % nblk, k0 = 64 * kb, n0 = 32 * nb;
#pragma unroll 8
    for (int i = 0; i < 32; ++i) { const int kk = 2 * i + (lane >> 5); float v = W[(size_t)(k0 + kk) * N + n0 + (lane & 31)]; if (kscale) v *= kscale[k0 + kk]; scr[kk * 33 + (lane & 31)] = v; }
    asm volatile("s_waitcnt lgkmcnt(0)" ::: "memory");
    const int c = lane & 7;
#pragma unroll
    for (int j = 0; j < 4; ++j) { const int n = (lane >> 3) + 8 * j; const LAS float* s = scr + (8 * c) * 33 + n;
        v4u o; o.x = pk2(s[0 * 33], s[1 * 33]); o.y = pk2(s[2 * 33], s[3 * 33]); o.z = pk2(s[4 * 33], s[5 * 33]); o.w = pk2(s[6 * 33], s[7 * 33]);
        const int sc = n0 + n; const int row = MAP == 1 ? map_win(sc) : MAP == 2 ? map_wup(sc) : sc;
        *(v4u*)(WT + (size_t)row * K + k0 + 8 * c) = o; }
    asm volatile("s_waitcnt lgkmcnt(0)" ::: "memory");
}
__device__ __forceinline__ void rms_row_bf16(const float* xrow, const float* g, bf16* orow, int lane) {
    const f32x4* xr = (const f32x4*)xrow + lane; const f32x4* gr = (const f32x4*)g + lane;
    f32x4 v[4]; float s = 0.f;
#pragma unroll
    for (int j = 0; j < 4; ++j) { v[j] = xr[64 * j]; s += (v[j][0] * v[j][0] + v[j][1] * v[j][1]) + (v[j][2] * v[j][2] + v[j][3] * v[j][3]); }
    const float rstd = 1.0f / sqrtf(wave_sum(s) * (1.0f / DM) + RMS_EPS);
    unsigned long long* o8 = (unsigned long long*)orow + lane;
#pragma unroll
    for (int j = 0; j < 4; ++j) { const f32x4 gg = gr[64 * j]; o8[64 * j] = (unsigned long long)pk2(v[j][0] * rstd * gg[0], v[j][1] * rstd * gg[1]) | ((unsigned long long)pk2(v[j][2] * rstd * gg[2], v[j][3] * rstd * gg[3]) << 32); }
}
__device__ __forceinline__ void rms_rows4_bf16(const float* x0, const float* g, bf16* o0, int lane) {
    f32x4 v[4][4]; float s[4];
#pragma unroll
    for (int r = 0; r < 4; ++r) { const f32x4* xr = (const f32x4*)(x0 + (size_t)r * DM) + lane; s[r] = 0.f;
#pragma unroll
        for (int j = 0; j < 4; ++j) { v[r][j] = xr[64 * j]; } }
#pragma unroll
    for (int r = 0; r < 4; ++r)
#pragma unroll
        for (int j = 0; j < 4; ++j) s[r] += (v[r][j][0] * v[r][j][0] + v[r][j][1] * v[r][j][1]) + (v[r][j][2] * v[r][j][2] + v[r][j][3] * v[r][j][3]);
    const f32x4* gr = (const f32x4*)g + lane;
#pragma unroll
    for (int r = 0; r < 4; ++r) { const float rstd = 1.0f / sqrtf(wave_sum(s[r]) * (1.0f / DM) + RMS_EPS); unsigned long long* o8 = (unsigned long long*)(o0 + (size_t)r * DM) + lane;
#pragma unroll
        for (int j = 0; j < 4; ++j) { const f32x4 gg = gr[64 * j]; o8[64 * j] = (unsigned long long)pk2(v[r][j][0] * rstd * gg[0], v[r][j][1] * rstd * gg[1]) | ((unsigned long long)pk2(v[r][j][2] * rstd * gg[2], v[r][j][3] * rstd * gg[3]) << 32); } }
}
__device__ __forceinline__ void rms_rows4_f32(float* x0, const float* g, int lane) {
    f32x4 v[4][4]; float s[4];
#pragma unroll
    for (int r = 0; r < 4; ++r) { const f32x4* xr = (const f32x4*)(x0 + (size_t)r * DM) + lane; s[r] = 0.f;
#pragma unroll
        for (int j = 0; j < 4; ++j) { v[r][j] = xr[64 * j]; } }
#pragma unroll
    for (int r = 0; r < 4; ++r)
#pragma unroll
        for (int j = 0; j < 4; ++j) s[r] += (v[r][j][0] * v[r][j][0] + v[r][j][1] * v[r][j][1]) + (v[r][j][2] * v[r][j][2] + v[r][j][3] * v[r][j][3]);
    const f32x4* gr = (const f32x4*)g + lane;
#pragma unroll
    for (int r = 0; r < 4; ++r) { const float rstd = 1.0f / sqrtf(wave_sum(s[r]) * (1.0f / DM) + RMS_EPS); f32x4* xr = (f32x4*)(x0 + (size_t)r * DM) + lane;
#pragma unroll
        for (int j = 0; j < 4; ++j) xr[64 * j] = v[r][j] * rstd * gr[64 * j]; }
}
__device__ __forceinline__ void rms_row_f32(float* xrow, const float* g, int lane) {
    f32x4* xr = (f32x4*)xrow + lane; const f32x4* gr = (const f32x4*)g + lane;
    f32x4 v[4]; float s = 0.f;
#pragma unroll
    for (int j = 0; j < 4; ++j) { v[j] = xr[64 * j]; s += (v[j][0] * v[j][0] + v[j][1] * v[j][1]) + (v[j][2] * v[j][2] + v[j][3] * v[j][3]); }
    const float rstd = 1.0f / sqrtf(wave_sum(s) * (1.0f / DM) + RMS_EPS);
#pragma unroll
    for (int j = 0; j < 4; ++j) xr[64 * j] = v[j] * rstd * gr[64 * j];
}

#ifndef DUP_MASK
#define DUP_MASK 0
#endif
#define TPROBE_BEGIN(bit) do { if ((DUP_MASK >> (bit)) & 1) { if (lane == 0) *(volatile LAS unsigned long long*)(lds + 163000 + wave * 8) = __builtin_amdgcn_s_memrealtime(); } } while (0)
#define TPROBE_END(bit) do { if ((DUP_MASK >> (bit)) & 1) { asm volatile("s_waitcnt vmcnt(0) lgkmcnt(0)" ::: "memory"); const unsigned long long t1_ = __builtin_amdgcn_s_memrealtime(); const unsigned long long t0_ = *(volatile LAS unsigned long long*)(lds + 163000 + (tid >> 6) * 8); \
    const unsigned long long d_ = __builtin_amdgcn_readfirstlane((unsigned)(t1_ - t0_)); while (__builtin_amdgcn_s_memrealtime() - t1_ < d_) __builtin_amdgcn_s_sleep(16); } } while (0)
struct Args { const float* in[13]; float* out; unsigned char* ws; };

__global__ void __launch_bounds__(NWAVES * 64, 2) mega_fwd(Args args) {
    extern __shared__ __attribute__((aligned(16))) unsigned char lds_raw[];
    cg::grid_group grid = cg::this_grid();
    LAS unsigned char* lds = (LAS unsigned char*)lds_raw;
    const int tid = threadIdx.x, lane = tid & 63, wave = __builtin_amdgcn_readfirstlane(tid >> 6);
    const int G = gridDim.x, bx = blockIdx.x;
    volatile LAS unsigned* MISC = (volatile LAS unsigned*)(lds + 163200);
    if (tid < 8) MISC[tid] = 0u;
    __syncthreads();
    const float* x = args.in[0]; const float* g_mix = args.in[1]; const float* w_in = args.in[2]; const float* b_gate = args.in[3];
    const float* w_a = args.in[4]; const float* w_b = args.in[5]; const float* w_out = args.in[6]; const float* g_ffn = args.in[7];
    const float* w_up = args.in[8]; const float* conv_w = args.in[9]; const float* conv_b = args.in[10]; const float* w_down = args.in[11]; const float* g_final = args.in[12];
    float* out = args.out; unsigned char* ws = args.ws;
    bf16 *Win = (bf16*)(ws + WS_WIN), *Wa = (bf16*)(ws + WS_WA), *Wb = (bf16*)(ws + WS_WB), *Wout = (bf16*)(ws + WS_WOUT), *Wup = (bf16*)(ws + WS_WUP), *Wdn = (bf16*)(ws + WS_WDN);
    float *CS = (float*)(ws + WS_CS), *KMP = (float*)(ws + WS_KMP), *SSQ = (float*)(ws + WS_SSQ), *HALO = (float*)(ws + WS_HALO), *RAW = (float*)(ws + WS_RAW);
    bf16 *XN = (bf16*)(ws + WS_XN), *QA = (bf16*)(ws + WS_QA), *KA = (bf16*)(ws + WS_KA), *QB = (bf16*)(ws + WS_QB), *KB = (bf16*)(ws + WS_KB), *VT = (bf16*)(ws + WS_VT), *GT = (bf16*)(ws + WS_G);
    bf16 *YA = (bf16*)(ws + WS_YA), *YB = (bf16*)(ws + WS_YB), *MRG = (bf16*)(ws + WS_MRG), *X1B = (bf16*)(ws + WS_X1B), *ACT = (bf16*)(ws + WS_ACT);

    {
        LAS float* scr = (LAS float*)(lds + wave * 16384);
        const int gw = bx * NWAVES + wave, NGW = G * NWAVES;
        constexpr int I_IN = (DM / 64) * (5120 / 32), I_A = (512 / 64) * (DM / 32), I_O = (DM / 64) * (DM / 32), I_UP = (DM / 64) * (NUP / 32), I_DN = (DFF / 64) * (DM / 32);
        constexpr int NITEMS = I_IN + 2 * I_A + I_O + I_UP + I_DN;
        for (int it = gw; it < NITEMS; it += NGW) {
            int r = it;
            if (r < I_IN) { transpose_item<1>(w_in, DM, 5120, Win, nullptr, scr, r, lane); continue; } r -= I_IN;
            if (r < I_A) { transpose_item<0>(w_a, 512, DM, Wa, nullptr, scr, r, lane); continue; } r -= I_A;
            if (r < I_A) { transpose_item<0>(w_b, 512, DM, Wb, nullptr, scr, r, lane); continue; } r -= I_A;
            if (r < I_O) { transpose_item<0>(w_out, DM, DM, Wout, nullptr, scr, r, lane); continue; } r -= I_O;
            if (r < I_UP) { transpose_item<2>(w_up, DM, NUP, Wup, g_ffn, scr, r, lane); continue; } r -= I_UP;
            transpose_item<0>(w_down, DFF, DM, Wdn, nullptr, scr, r, lane);
        }
        for (int m = gw * 4; m < M_TOK; m += NGW * 4) rms_rows4_bf16(x + (size_t)m * DM, g_mix, XN + (size_t)m * DM, lane);
        if (bx == 0) { unsigned* bw = (unsigned*)(ws + WS_CTL); for (int k_ = tid; k_ < XCD_BAR_WORDS; k_ += 512) bw[k_] = 0u; }
        for (int e = bx * 512 + tid; e < SEQ * 32; e += G * 512) { const int pos = e >> 5, fi = e & 31;
            double inv = 1.0; for (int k = 0; k < fi; ++k) inv *= 0.7498942093324558;
            const float ang = (float)pos * (float)inv; const double rv = (double)ang * 0.15915494309189535; const float fr_ = (float)(rv - __builtin_rint(rv));
            CS[(size_t)pos * 64 + fi] = __builtin_amdgcn_cosf(fr_); CS[(size_t)pos * 64 + 32 + fi] = __builtin_amdgcn_sinf(fr_); }
    }
    grid.sync();
    XcdBarrier bar = xcd_barrier_post((unsigned*)(ws + WS_CTL), MISC);
    {
        pg8::Gemm g{XN, Win, M_TOK, 4096, DM}; pg8::StaticOrder S; S.init(M_TOK, 4096, G, bx);
        pg8::EpiInProj E{QA, KA, QB, KB, GT, b_gate, CS, KMP};
        pg8::gemm_phase<pg8::EpiInProj, pg8::StaticOrder, true, true>(lds, g, S, E);
        pg8::Gemm g2{Win + (size_t)4096 * DM, XN, 1024, M_TOK, DM}; pg8::StaticOrder S2; S2.init(1024, M_TOK, G, bx);
        pg8::EpiPlain E2{VT, VT_PITCH, 1.0f};
        pg8::gemm_phase<pg8::EpiPlain, pg8::StaticOrder, true, true>(lds, g2, S2, E2);
    }
    xcd_barrier(bar);
    {
        const int vcu = (G % 8 == 0) ? (bx % 8) * (G / 8) + bx / 8 : bx;
        for (int n = vcu; n < 512; n += G) { const int c = n & 255, rnd = n >> 8; const int bh = (c >> 5) + 8 * rnd, l = c & 31; const int i = rnd ? 31 - l : l;
            att::moba_unit(lds, QA, KA, VT, KMP, YA, bh >> 3, bh & 7, i); }
        const int gw = vcu * NWAVES + wave, NGW = G * NWAVES;
        for (int un = gw; un < 8192; un += NGW) { const int bh = un >> 9, qg = un & 511; att::sb_unit(QB, KB, VT, YB, bh >> 3, bh & 7, qg, lane); }
    }
    xcd_barrier(bar);
    {
        pg8::Gemm g{YA, Wa, M_TOK, DM, 512}; pg8::StaticOrder S; S.init(M_TOK, DM, G, bx);
        pg8::EpiBranch<0> E{MRG, GT};
        pg8::gemm_phase<pg8::EpiBranch<0>, pg8::StaticOrder, true, true>(lds, g, S, E);
        pg8::Gemm g2{YB, Wb, M_TOK, DM, 512};
        pg8::EpiBranch<1> E2{MRG, GT};
        pg8::gemm_phase<pg8::EpiBranch<1>, pg8::StaticOrder, true, true>(lds, g2, S, E2);
    }
    xcd_barrier(bar);
    {
        pg8::Gemm g{MRG, Wout, M_TOK, DM, DM}; pg8::StaticOrder S; S.init(M_TOK, DM, G, bx);
        pg8::EpiResid<true> E{x, out, X1B, SSQ};
        pg8::gemm_phase<pg8::EpiResid<true>, pg8::StaticOrder, true, true>(lds, g, S, E);
    }
    xcd_barrier(bar);
    TPROBE_BEGIN(6);
    {
        pg8::Gemm g{X1B, Wup, M_TOK, NUP, DM}; pg8::StaticOrder S; S.init(M_TOK, NUP, G, bx);
        pg8::EpiUp E{ACT, SSQ, conv_w, conv_b, HALO, RAW, (LAS float*)(lds + EXCH_OFF)};
        pg8::gemm_phase<pg8::EpiUp, pg8::StaticOrder, true, true>(lds, g, S, E);
    }
    TPROBE_END(6);
    if ((DUP_MASK >> 12) & 1) { for (int k_ = 0; k_ < 6; ++k_) xcd_barrier(bar); }
    xcd_barrier(bar);
    TPROBE_BEGIN(7);
    {
        pg8::StaticOrder S; S.init(M_TOK, DM, G, bx); pg8::Unit u;
        for (int ui = 0; S.next(ui, u); ++ui) {
            const int pm = u.pm; const bool hasprev = (pm & 31) != 0;
            for (int idx = tid; idx < 2 * DFF; idx += 512) { const int r = idx >= DFF ? 1 : 0, c = idx - r * DFF; const int gc = 256 * (c >> 7) + (c & 127);
                float a2[2];
#pragma unroll
                for (int v = 0; v < 2; ++v) { const int tc = gc + 128 * v, cc = c + v * DFF;
                    const float h0 = hasprev ? HALO[(size_t)((pm - 1) * 2 + 0) * NUP + tc] : 0.f, h1 = hasprev ? HALO[(size_t)((pm - 1) * 2 + 1) * NUP + tc] : 0.f;
                    const float r0 = RAW[(size_t)(pm * 2 + 0) * NUP + tc], r1 = RAW[(size_t)(pm * 2 + 1) * NUP + tc];
                    const float cur = r ? r1 : r0, p1 = r ? r0 : h1, p2 = r ? h1 : h0;
                    a2[v] = (conv_w[cc] * p2 + conv_w[NUP + cc] * p1) + (conv_w[2 * NUP + cc] * cur + conv_b[cc]); }
                const float act = a2[0] * pg8::sigmoidf_(a2[0]) * a2[1];
                ACT[(size_t)(pm * 256 + r) * DFF + c] = (bf16)f2bf(act); }
        }
        __threadfence(); __syncthreads(); __builtin_amdgcn_fence(__ATOMIC_ACQUIRE, "agent"); asm volatile("s_waitcnt vmcnt(0)" ::: "memory"); __syncthreads();
        pg8::Gemm g{ACT, Wdn, M_TOK, DM, DFF};
        pg8::EpiResid<false> E{out, out, nullptr, nullptr};
        pg8::gemm_phase<pg8::EpiResid<false>, pg8::StaticOrder, true, true>(lds, g, S, E);
    }
    TPROBE_END(7);
    xcd_barrier(bar);
    {
        const int gw = bx * NWAVES + wave, NGW = G * NWAVES;
        for (int m = gw * 4; m < M_TOK; m += NGW * 4) rms_rows4_f32(out + (size_t)m * DM, g_final, lane);
    }
}

extern "C" void kernel_launch(void* const* d_in, const int* in_sizes, int n_in, void* d_out, int out_size, void* d_ws, size_t ws_size, hipStream_t stream) {
    static int grid = 0;
    if (grid == 0) {
        if (n_in != 13 || out_size != M_TOK * DM || ws_size < WS_END) { fprintf(stderr, "kernel_launch: unexpected shapes (n_in %d out %d ws %zu)\n", n_in, out_size, ws_size); grid = -1; return; }
        int dev = 0, cus = 0, per_cu = 0;
        hipGetDevice(&dev); hipDeviceGetAttribute(&cus, hipDeviceAttributeMultiprocessorCount, dev);
        hipFuncSetAttribute((const void*)mega_fwd, hipFuncAttributeMaxDynamicSharedMemorySize, LDS_BYTES);
        if (hipOccupancyMaxActiveBlocksPerMultiprocessor(&per_cu, (const void*)mega_fwd, NWAVES * 64, LDS_BYTES) != hipSuccess || per_cu < 1) { fprintf(stderr, "kernel_launch: occupancy query says %d\n", per_cu); per_cu = 1; }
        (void)hipGetLastError();
        grid = cus * 1;
    }
    if (grid < 0) return;
    Args a{};
    for (int i = 0; i < 13; ++i) a.in[i] = (const float*)d_in[i];
    a.out = (float*)d_out; a.ws = (unsigned char*)d_ws;
    void* params[] = {&a};
    hipError_t e = hipLaunchCooperativeKernel((const void*)mega_fwd, dim3(grid), dim3(NWAVES * 64), params, LDS_BYTES, stream);
    if (e != hipSuccess) fprintf(stderr, "cooperative launch failed: %s (grid %d)\n", hipGetErrorString(e), grid);
}
```

```cpp
#include <hip/hip_runtime.h>
#include <hip/hip_cooperative_groups.h>
#include <cstdio>
#include <cstdint>
namespace cg = cooperative_groups;
namespace pg8 {
#define PG8_LAS __attribute__((address_space(3)))
typedef unsigned short bf16_t;
typedef short bf16x8 __attribute__((ext_vector_type(8)));
typedef float f32x4 __attribute__((ext_vector_type(4)));
typedef unsigned u32x4 __attribute__((ext_vector_type(4)));
constexpr int BM = 256, BK = 64, HALF = 128, HTB = HALF * BK * 2  , STAGE_BYTES = 8 * HTB, NXCD = 8, WGM = 8;

__host__ __device__ __forceinline__ int lds_byte(int r, int c) { const int st = (r >> 4) * 2 + (c >> 5), rr = r & 15, cc = c & 31, ob = rr * 64 + cc * 2; return st * 1024 + (ob ^ (((ob >> 9) & 1) << 5)); }
__host__ __device__ __forceinline__ void stage_rc(int b, int& R, int& C) { const int st = b / 1024, sb = b % 1024, swz = sb ^ (((sb >> 9) & 1) << 5); R = (st >> 1) * 16 + swz / 64; C = (st & 1) * 32 + (swz % 64) / 2; }
__host__ __device__ __forceinline__ int perm32(int rho) { const int n = rho >> 4, i = rho & 15; return 8 * (i >> 2) + 4 * n + (i & 3); }

struct Unit { int pm, pn; };
struct Gemm { const bf16_t* A; const bf16_t* Bt; int M, N, K; };

struct StaticOrder {
    int nM, nN, nwg, G, c;
    __host__ __device__ void init(int M, int N, int G_, int c_) { nM = M / BM; nN = N / BM; nwg = nM * nN; G = G_; c = c_; }
    __host__ __device__ bool next(int i, Unit& u) const {
        const long L = (long)i * G + c; if (L >= nwg) return false;
        int wgid = (int)L; { const int q = nwg / NXCD, r = nwg % NXCD, xcd = wgid % NXCD, off = wgid / NXCD; wgid = (xcd < r ? xcd * (q + 1) : r * (q + 1) + (xcd - r) * q) + off; }
        const int nig = WGM * nN, gid = wgid / nig, fm = gid * WGM, gsz = (nM - fm) < WGM ? (nM - fm) : WGM;
        u.pm = fm + ((wgid % nig) % gsz); u.pn = (wgid % nig) / gsz; return true;
    }
    __device__ __forceinline__ void a_ready(const Unit&) const {}
    __device__ __forceinline__ void done(const Unit&) const {}
};

typedef float f32x2c_t __attribute__((ext_vector_type(2))); typedef __bf16 bf16x2c_t __attribute__((ext_vector_type(2)));
__device__ __forceinline__ unsigned cvt_pk_bf16(float lo, float hi) { f32x2c_t v = {lo, hi}; bf16x2c_t b = __builtin_convertvector(v, bf16x2c_t); return __builtin_bit_cast(unsigned, b); }
typedef float f32x2 __attribute__((ext_vector_type(2)));
template <class Epi, class Sched, bool ALIGN_EPI = false, bool SP2 = false>
__device__ __forceinline__ void gemm_phase(PG8_LAS unsigned char* lds, const Gemm g, const Sched& S, const Epi& E) {
    int tid_ = threadIdx.x; asm volatile("" : "+v"(tid_));
    const int tid = tid_, wid = __builtin_amdgcn_readfirstlane(tid >> 6), lane = tid & 63, wr = wid >> 2, wc = wid & 3, fr = lane & 15, fq = lane >> 4;
    const int K = g.K, nt = K / BK;
    unsigned voffA[2], voffB[2];
#pragma unroll
    for (int i = 0; i < 2; ++i) { int R, C; stage_rc(tid * 16 + i * 8192, R, C); const int Rb = Epi::PERM ? ((R & ~31) + perm32(R & 31)) : R;
        voffA[i] = (unsigned)(R * K + C) * 2u; voffB[i] = (unsigned)(Rb * K + C) * 2u; }
    const size_t kstep = (size_t)(BK * 2);
    const size_t hstep = (size_t)HALF * K * 2;
    const size_t tstep = 2 * hstep;
    const unsigned ldsw = (unsigned)wid * 1024u;
    const int aoff = lds_byte(wr * 64 + fr, fq * 8), boff = lds_byte(wc * 32 + fr, fq * 8);
#define PG8_SA(b, h) (((b) * 2 + (h)) * HTB)
#define PG8_SB(b, h) ((4 + (b) * 2 + (h)) * HTB)
#define PG8_STAGE(bufoff, gbase, voff) do { _Pragma("unroll") for (int _i = 0; _i < 2; ++_i) \
        __builtin_amdgcn_global_load_lds((const unsigned*)((const char*)(gbase) + (voff)[_i]), (PG8_LAS unsigned*)(lds + (bufoff) + ldsw + _i * 8192), 16, 0, 0); } while (0)
#define PG8_LDA(dst, b, h) do { _Pragma("unroll") for (int m = 0; m < 4; ++m) _Pragma("unroll") for (int k = 0; k < 2; ++k) dst[m][k] = *(const PG8_LAS bf16x8*)(lds + PG8_SA(b, h) + aoff + m * 2048 + k * 1024); } while (0)
#define PG8_LDB(dst, b, h) do { _Pragma("unroll") for (int n = 0; n < 2; ++n) _Pragma("unroll") for (int k = 0; k < 2; ++k) dst[n][k] = *(const PG8_LAS bf16x8*)(lds + PG8_SB(b, h) + boff + n * 2048 + k * 1024); } while (0)
#define PG8_MMA(ai, bj, At, Bt) do { __builtin_amdgcn_s_setprio(1); _Pragma("unroll") for (int m = 0; m < 4; ++m) _Pragma("unroll") for (int n = 0; n < 2; ++n) _Pragma("unroll") for (int k = 0; k < 2; ++k) \
        acc[ai][bj][m][n] = __builtin_amdgcn_mfma_f32_16x16x32_bf16(Bt[n][k], At[m][k], acc[ai][bj][m][n], 0, 0, 0); __builtin_amdgcn_s_setprio(0); } while (0)
#define PG8_WAIT_V(n) asm volatile("s_waitcnt vmcnt(" #n ")" ::: "memory")
#define PG8_WAIT_L(n) asm volatile("s_waitcnt lgkmcnt(" #n ")" ::: "memory")
#define PG8_BAR __builtin_amdgcn_s_barrier()
#define PG8_SCHED __builtin_amdgcn_sched_barrier(0)
    Unit cur, nxt; int ui = 0;
    if (!S.next(0, cur)) return;
    f32x4 acc[2][2][4][2];
#pragma unroll
    for (int a = 0; a < 2; ++a)
#pragma unroll
        for (int b = 0; b < 2; ++b)
#pragma unroll
            for (int m = 0; m < 4; ++m)
#pragma unroll
                for (int n = 0; n < 2; ++n) acc[a][b][m][n] = (f32x4){0.f, 0.f, 0.f, 0.f};
    bf16x8 At[4][2], B0[2][2], B1[2][2];
    const char* cA = (const char*)g.A + (size_t)cur.pm * tstep; const char* cB = (const char*)g.Bt + (size_t)cur.pn * tstep;
    S.a_ready(cur);
    if constexpr (SP2) {
        PG8_STAGE(PG8_SB(0, 0), cB, voffB); PG8_STAGE(PG8_SB(0, 1), cB + hstep, voffB); PG8_STAGE(PG8_SA(0, 0), cA, voffA); PG8_STAGE(PG8_SA(0, 1), cA + hstep, voffA);
        if (wr == 1) PG8_BAR;
        PG8_WAIT_V(2); PG8_BAR;
        PG8_STAGE(PG8_SB(1, 0), cB + kstep, voffB); PG8_STAGE(PG8_SA(1, 0), cA + kstep, voffA); PG8_STAGE(PG8_SB(1, 1), cB + hstep + kstep, voffB);
        PG8_WAIT_V(6); PG8_BAR;
    } else {
        PG8_STAGE(PG8_SB(0, 0), cB, voffB); PG8_STAGE(PG8_SA(0, 0), cA, voffA); PG8_STAGE(PG8_SB(0, 1), cB + hstep, voffB); PG8_STAGE(PG8_SA(0, 1), cA + hstep, voffA);
        if (wr == 1) PG8_BAR;
        PG8_WAIT_V(4); PG8_BAR;
        PG8_STAGE(PG8_SB(1, 0), cB + kstep, voffB); PG8_STAGE(PG8_SA(1, 0), cA + kstep, voffA); PG8_STAGE(PG8_SB(1, 1), cB + hstep + kstep, voffB);
        PG8_WAIT_V(6); PG8_BAR;
    }
    for (;;) {
        const bool has_next = S.next(ui + 1, nxt);
        const char* nA = has_next ? (const char*)g.A + (size_t)nxt.pm * tstep : cA; const char* nB = has_next ? (const char*)g.Bt + (size_t)nxt.pn * tstep : cB;
        for (int t = 0; t < nt; t += 2) {
            const bool last = (t == nt - 2);
            const char* a1 = cA + (size_t)(t + 1) * kstep;
            const char* a2 = last ? nA : cA + (size_t)(t + 2) * kstep; const char* b2 = last ? nB : cB + (size_t)(t + 2) * kstep;
            const char* a3 = a2 + kstep; const char* b3 = b2 + kstep;
            if (last && has_next) S.a_ready(nxt);
            if constexpr (SP2) {
            PG8_LDB(B0, 0, 0); PG8_LDB(B1, 0, 1); PG8_SCHED; PG8_LDA(At, 0, 0); PG8_STAGE(PG8_SA(1, 1), a1 + hstep, voffA);
            PG8_WAIT_V(8); PG8_WAIT_L(0); PG8_BAR; PG8_MMA(0, 0, At, B0); PG8_MMA(0, 1, At, B1); PG8_BAR; PG8_SCHED;
            PG8_LDA(At, 0, 1); PG8_STAGE(PG8_SB(0, 0), b2, voffB); PG8_STAGE(PG8_SB(0, 1), b2 + hstep, voffB); PG8_STAGE(PG8_SA(0, 0), a2, voffA);
            PG8_WAIT_V(8); PG8_WAIT_L(0); PG8_BAR; PG8_MMA(1, 0, At, B0); PG8_MMA(1, 1, At, B1); PG8_BAR; PG8_SCHED;
            PG8_LDB(B0, 1, 0); PG8_LDB(B1, 1, 1); PG8_SCHED; PG8_LDA(At, 1, 0); PG8_STAGE(PG8_SA(0, 1), a2 + hstep, voffA);
            PG8_WAIT_V(8); PG8_WAIT_L(0); PG8_BAR; PG8_MMA(0, 0, At, B0); PG8_MMA(0, 1, At, B1); PG8_BAR; PG8_SCHED;
            PG8_LDA(At, 1, 1); PG8_STAGE(PG8_SB(1, 0), b3, voffB); PG8_STAGE(PG8_SB(1, 1), b3 + hstep, voffB); PG8_STAGE(PG8_SA(1, 0), a3, voffA);
            PG8_WAIT_V(8); PG8_WAIT_L(0); PG8_BAR; PG8_MMA(1, 0, At, B0); PG8_MMA(1, 1, At, B1); PG8_BAR; PG8_SCHED;
            } else {
            PG8_LDB(B0, 0, 0); PG8_SCHED; PG8_LDA(At, 0, 0); PG8_STAGE(PG8_SA(1, 1), a1 + hstep, voffA);
            PG8_WAIT_L(8); PG8_BAR; PG8_WAIT_L(0); PG8_MMA(0, 0, At, B0); PG8_BAR; PG8_SCHED;
            PG8_LDB(B1, 0, 1); PG8_STAGE(PG8_SB(0, 0), b2, voffB);
            PG8_BAR; PG8_WAIT_L(0); PG8_MMA(0, 1, At, B1); PG8_BAR;
            PG8_LDA(At, 0, 1); PG8_STAGE(PG8_SA(0, 0), a2, voffA);
            PG8_BAR; PG8_WAIT_L(0); PG8_MMA(1, 0, At, B0); PG8_BAR; PG8_SCHED;
            PG8_STAGE(PG8_SB(0, 1), b2 + hstep, voffB);
            PG8_WAIT_V(6); PG8_BAR; PG8_MMA(1, 1, At, B1); PG8_BAR;
            PG8_LDB(B0, 1, 0); PG8_SCHED; PG8_LDA(At, 1, 0); PG8_STAGE(PG8_SA(0, 1), a2 + hstep, voffA);
            PG8_WAIT_L(8); PG8_BAR; PG8_WAIT_L(0); PG8_MMA(0, 0, At, B0); PG8_BAR; PG8_SCHED;
            PG8_LDB(B1, 1, 1); PG8_STAGE(PG8_SB(1, 0), b3, voffB);
            PG8_BAR; PG8_WAIT_L(0); PG8_MMA(0, 1, At, B1); PG8_BAR;
            PG8_LDA(At, 1, 1); PG8_STAGE(PG8_SA(1, 0), a3, voffA);
            PG8_BAR; PG8_WAIT_L(0); PG8_MMA(1, 0, At, B0); PG8_BAR; PG8_SCHED;
            PG8_STAGE(PG8_SB(1, 1), b3 + hstep, voffB);
            PG8_WAIT_V(6); PG8_BAR; PG8_MMA(1, 1, At, B1); PG8_BAR;
            }
        }
        if constexpr (ALIGN_EPI) { if (wr == 0) PG8_BAR; }
        if constexpr (!Epi::AFTER_DRAIN) { E(acc, cur, wr, wc, fr, fq); S.done(cur); }
        if (!has_next) break;
#pragma unroll
        for (int a = 0; a < 2; ++a)
#pragma unroll
            for (int b = 0; b < 2; ++b)
#pragma unroll
                for (int m = 0; m < 4; ++m)
#pragma unroll
                    for (int n = 0; n < 2; ++n) acc[a][b][m][n] = (f32x4){0.f, 0.f, 0.f, 0.f};
        cur = nxt; cA = nA; cB = nB; ++ui;
        if constexpr (ALIGN_EPI) { if (wr == 1) PG8_BAR; }
    }
    PG8_WAIT_V(0);
    if constexpr (!ALIGN_EPI) { if (wr == 0) PG8_BAR; }
    PG8_BAR;
    if constexpr (Epi::AFTER_DRAIN) { E.fused(acc, cur, wr, wc, fr, fq, lds, wid, lane); S.done(cur); }
#undef PG8_SA
#undef PG8_SB
#undef PG8_STAGE
#undef PG8_LDA
#undef PG8_LDB
#undef PG8_MMA
#undef PG8_WAIT_V
#undef PG8_WAIT_L
#undef PG8_BAR
#undef PG8_SCHED
}
}
constexpr int M_TOK = 16384, SEQ = 8192, DM = 1024, DFF = 2816, NUP = 5632;
constexpr float RMS_EPS = 1e-6f;
constexpr float QC2 = 0.18033688011112042f;
constexpr size_t MiB = 1u << 20;
constexpr size_t WS_WIN = 0;
constexpr size_t WS_WA = 10 * MiB;
constexpr size_t WS_WB = 11 * MiB;
constexpr size_t WS_WOUT = 12 * MiB;
constexpr size_t WS_WUP = 14 * MiB;
constexpr size_t WS_WDN = 25 * MiB;
constexpr size_t WS_CS = 31 * MiB;
constexpr size_t WS_KMP = 33 * MiB;
constexpr size_t WS_SSQ = 34 * MiB;
constexpr size_t WS_HALO = 35 * MiB;
constexpr size_t WS_RAW = 38 * MiB;
constexpr size_t WS_XN = 41 * MiB;
constexpr size_t WS_QA = 73 * MiB;
constexpr size_t WS_KA = 89 * MiB;
constexpr size_t WS_QB = 105 * MiB;
constexpr size_t WS_KB = 121 * MiB;
constexpr int VT_PITCH = 16384 + 64;
constexpr size_t WS_VT = 137 * MiB;
constexpr size_t WS_G = 170 * MiB;
constexpr size_t WS_YA = 234 * MiB;
constexpr size_t WS_YB = 41 * MiB;
constexpr size_t WS_MRG = 57 * MiB;
constexpr size_t WS_X1B = 89 * MiB;
constexpr size_t WS_ACT = 121 * MiB;
constexpr size_t WS_END = 250 * MiB;

namespace pg8 {
__device__ __forceinline__ float sigmoidf_(float v) { return __builtin_amdgcn_rcpf(1.0f + __expf(-v)); }
typedef unsigned u32x2 __attribute__((ext_vector_type(2)));

struct EpiPlain {
    static constexpr bool PERM = true, AFTER_DRAIN = false;
    bf16_t* O; int ldc; float scale;
    __device__ __forceinline__ void operator()(f32x4 (&acc)[2][2][4][2], const Unit& u, int wr, int wc, int fr, int fq) const {
        const int row0 = u.pm * BM + wr * 64 + fr, col0 = u.pn * BM + wc * 32 + 8 * fq;
#pragma unroll
        for (int ai = 0; ai < 2; ++ai)
#pragma unroll
            for (int m = 0; m < 4; ++m) { bf16_t* rowp = O + (size_t)(row0 + ai * HALF + m * 16) * ldc + col0;
#pragma unroll
                for (int bj = 0; bj < 2; ++bj) { const f32x4 v0 = acc[ai][bj][m][0] * scale, v1 = acc[ai][bj][m][1] * scale;
                    u32x4 w; w.x = cvt_pk_bf16(v0[0], v0[1]); w.y = cvt_pk_bf16(v0[2], v0[3]); w.z = cvt_pk_bf16(v1[0], v1[1]); w.w = cvt_pk_bf16(v1[2], v1[3]);
                    *(u32x4*)(rowp + bj * HALF) = w; } }
    }
};

struct EpiInProj {
    static constexpr bool PERM = true, AFTER_DRAIN = false;
    bf16_t *QA, *KA, *QB, *KB, *G; const float* bgate; const float* cs; float* kmp;
    __device__ __forceinline__ void operator()(f32x4 (&acc)[2][2][4][2], const Unit& u, int wr, int wc, int fr, int fq) const {
        const int row0 = u.pm * BM + wr * 64 + fr;
        if (u.pn < 4) {
            const bool isk = u.pn >= 2; bf16_t* O = isk ? KA : QA; const int pnl = u.pn & 1; const float sc = isk ? 1.0f : QC2;
            const int d0 = 16 * (wc & 1) + 4 * fq;
            f32x4 ks[2][2];
#pragma unroll
            for (int bj = 0; bj < 2; ++bj) { ks[bj][0] = (f32x4){0.f, 0.f, 0.f, 0.f}; ks[bj][1] = (f32x4){0.f, 0.f, 0.f, 0.f}; }
#pragma unroll
            for (int ai = 0; ai < 2; ++ai)
#pragma unroll
                for (int m = 0; m < 4; ++m) { const int row = row0 + ai * HALF + m * 16, pos = row & (SEQ - 1);
                    const f32x4 c = *(const f32x4*)(cs + (size_t)pos * 64 + d0), s = *(const f32x4*)(cs + (size_t)pos * 64 + 32 + d0);
#pragma unroll
                    for (int bj = 0; bj < 2; ++bj) { const f32x4 v0 = acc[ai][bj][m][0], v1 = acc[ai][bj][m][1];
                        f32x4 o1 = v0 * c - v1 * s, o2 = v1 * c + v0 * s;
                        ks[bj][0] += o1; ks[bj][1] += o2;
                        o1 = o1 * sc; o2 = o2 * sc;
                        const int head = 4 * pnl + 2 * bj + (wc >> 1);
                        bf16_t* p = O + ((size_t)((row >> 13) * 8 + head) * SEQ + pos) * 64 + d0;
                        u32x2 w1, w2; w1.x = cvt_pk_bf16(o1[0], o1[1]); w1.y = cvt_pk_bf16(o1[2], o1[3]); w2.x = cvt_pk_bf16(o2[0], o2[1]); w2.y = cvt_pk_bf16(o2[2], o2[3]);
                        *(u32x2*)p = w1; *(u32x2*)(p + 32) = w2; } }
            if (isk) {
#pragma unroll
                for (int bj = 0; bj < 2; ++bj)
#pragma unroll
                    for (int hh = 0; hh < 2; ++hh) { f32x4 v = ks[bj][hh];
#pragma unroll
                        for (int o = 1; o < 16; o <<= 1) { v[0] += __shfl_xor(v[0], o); v[1] += __shfl_xor(v[1], o); v[2] += __shfl_xor(v[2], o); v[3] += __shfl_xor(v[3], o); }
                        if (fr == 0) { const int head = 4 * pnl + 2 * bj + (wc >> 1); *(f32x4*)(kmp + (size_t)(u.pm * 2 + wr) * 512 + head * 64 + hh * 32 + d0) = v; } }
            }
        } else if (u.pn < 8) {
            const bool isk = u.pn >= 6; bf16_t* O = isk ? KB : QB; const float sc = isk ? 1.0f : 0.125f;
            const int hd0 = (u.pn & 1) * 4 + (wc >> 1), dd = (wc & 1) * 32 + 8 * fq;
#pragma unroll
            for (int ai = 0; ai < 2; ++ai)
#pragma unroll
                for (int m = 0; m < 4; ++m) { const int row = row0 + ai * HALF + m * 16, pos = row & (SEQ - 1);
#pragma unroll
                    for (int bj = 0; bj < 2; ++bj) { const f32x4 v0 = acc[ai][bj][m][0] * sc, v1 = acc[ai][bj][m][1] * sc;
                        u32x4 w; w.x = cvt_pk_bf16(v0[0], v0[1]); w.y = cvt_pk_bf16(v0[2], v0[3]); w.z = cvt_pk_bf16(v1[0], v1[1]); w.w = cvt_pk_bf16(v1[2], v1[3]);
                        *(u32x4*)(O + ((size_t)((row >> 13) * 8 + hd0 + 2 * bj) * SEQ + pos) * 64 + dd) = w; } }
        } else {
            const int col0 = (u.pn - 8) * BM + wc * 32 + 8 * fq;
            f32x4 bv[2][2];
#pragma unroll
            for (int bj = 0; bj < 2; ++bj)
#pragma unroll
                for (int n = 0; n < 2; ++n) bv[bj][n] = *(const f32x4*)(bgate + col0 + bj * HALF + 4 * n);
#pragma unroll
            for (int ai = 0; ai < 2; ++ai)
#pragma unroll
                for (int m = 0; m < 4; ++m) { bf16_t* rowp = G + (size_t)(row0 + ai * HALF + m * 16) * 2048 + col0;
#pragma unroll
                    for (int bj = 0; bj < 2; ++bj) { f32x4 v0 = acc[ai][bj][m][0] + bv[bj][0], v1 = acc[ai][bj][m][1] + bv[bj][1];
#pragma unroll
                        for (int e = 0; e < 4; ++e) { v0[e] = sigmoidf_(v0[e]); v1[e] = sigmoidf_(v1[e]); }
                        u32x4 w; w.x = cvt_pk_bf16(v0[0], v0[1]); w.y = cvt_pk_bf16(v0[2], v0[3]); w.z = cvt_pk_bf16(v1[0], v1[1]); w.w = cvt_pk_bf16(v1[2], v1[3]);
                        *(u32x4*)(rowp + bj * HALF) = w; } }
        }
    }
};

__device__ __forceinline__ float bf_lo(unsigned w) { return __uint_as_float(w << 16); }
__device__ __forceinline__ float bf_hi(unsigned w) { return __uint_as_float(w & 0xffff0000u); }

template <int MODE> struct EpiBranch {
    static constexpr bool PERM = true, AFTER_DRAIN = false;
    bf16_t* MRG; const bf16_t* G;
    __device__ __forceinline__ void operator()(f32x4 (&acc)[2][2][4][2], const Unit& u, int wr, int wc, int fr, int fq) const {
        const int row0 = u.pm * BM + wr * 64 + fr, col0 = u.pn * BM + wc * 32 + 8 * fq;
#pragma unroll
        for (int ai = 0; ai < 2; ++ai)
#pragma unroll
            for (int m = 0; m < 4; ++m) { const size_t row = (size_t)(row0 + ai * HALF + m * 16);
#pragma unroll
                for (int bj = 0; bj < 2; ++bj) { const int col = col0 + bj * HALF;
                    const u32x4 g = *(const u32x4*)(G + row * 2048 + MODE * 1024 + col);
                    f32x4 v0 = acc[ai][bj][m][0], v1 = acc[ai][bj][m][1];
                    v0[0] *= bf_lo(g.x); v0[1] *= bf_hi(g.x); v0[2] *= bf_lo(g.y); v0[3] *= bf_hi(g.y);
                    v1[0] *= bf_lo(g.z); v1[1] *= bf_hi(g.z); v1[2] *= bf_lo(g.w); v1[3] *= bf_hi(g.w);
                    if (MODE == 1) { const u32x4 t = *(const u32x4*)(MRG + row * 1024 + col);
                        v0[0] += bf_lo(t.x); v0[1] += bf_hi(t.x); v0[2] += bf_lo(t.y); v0[3] += bf_hi(t.y);
                        v1[0] += bf_lo(t.z); v1[1] += bf_hi(t.z); v1[2] += bf_lo(t.w); v1[3] += bf_hi(t.w); }
                    u32x4 w; w.x = cvt_pk_bf16(v0[0], v0[1]); w.y = cvt_pk_bf16(v0[2], v0[3]); w.z = cvt_pk_bf16(v1[0], v1[1]); w.w = cvt_pk_bf16(v1[2], v1[3]);
                    *(u32x4*)(MRG + row * 1024 + col) = w; } }
    }
};

template <bool WITH_B> struct EpiResid {
    static constexpr bool PERM = true, AFTER_DRAIN = false;
    const float* XIN; float* XOUT; bf16_t* XB; float* ssq;
    __device__ __forceinline__ void operator()(f32x4 (&acc)[2][2][4][2], const Unit& u, int wr, int wc, int fr, int fq) const {
        const int row0 = u.pm * BM + wr * 64 + fr, col0 = u.pn * BM + wc * 32 + 8 * fq;
#pragma unroll
        for (int ai = 0; ai < 2; ++ai)
#pragma unroll
            for (int m = 0; m < 4; ++m) { const size_t row = (size_t)(row0 + ai * HALF + m * 16); float sq = 0.f;
#pragma unroll
                for (int bj = 0; bj < 2; ++bj) { const size_t off = row * DM + col0 + bj * HALF;
                    const f32x4 v0 = acc[ai][bj][m][0] + *(const f32x4*)(XIN + off), v1 = acc[ai][bj][m][1] + *(const f32x4*)(XIN + off + 4);
                    *(f32x4*)(XOUT + off) = v0; *(f32x4*)(XOUT + off + 4) = v1;
                    if (WITH_B) { sq += (v0[0] * v0[0] + v0[1] * v0[1]) + (v0[2] * v0[2] + v0[3] * v0[3]) + (v1[0] * v1[0] + v1[1] * v1[1]) + (v1[2] * v1[2] + v1[3] * v1[3]);
                        u32x4 w; w.x = cvt_pk_bf16(v0[0], v0[1]); w.y = cvt_pk_bf16(v0[2], v0[3]); w.z = cvt_pk_bf16(v1[0], v1[1]); w.w = cvt_pk_bf16(v1[2], v1[3]);
                        *(u32x4*)(XB + off) = w; } }
                if (WITH_B) { sq += __shfl_xor(sq, 16); sq += __shfl_xor(sq, 32); if (fq == 0) ssq[row * 16 + u.pn * 4 + wc] = sq; } }
    }
};

#define DPP_F(old_, src_, ctrl_) __uint_as_float((unsigned)__builtin_amdgcn_update_dpp((int)__float_as_uint(old_), (int)__float_as_uint(src_), ctrl_, 0xf, 0xf, false))
struct EpiUp {
    static constexpr bool PERM = true, AFTER_DRAIN = false;
    bf16_t* ACT; const float* ssq; const float* cw; const float* cb; float* halo; float* raw; PG8_LAS float* xl;
    __device__ __forceinline__ void operator()(f32x4 (&acc)[2][2][4][2], const Unit& u, int wr, int wc, int fr, int fq) const {
        const int row0 = u.pm * BM + wr * 64 + fr, tcol = wc * 32 + 8 * fq;
#pragma unroll
        for (int ai = 0; ai < 2; ++ai)
#pragma unroll
            for (int m = 0; m < 4; ++m) { const f32x4 p = *(const f32x4*)(ssq + (size_t)(row0 + ai * HALF + m * 16) * 16 + 4 * fq);
                float s = (p[0] + p[1]) + (p[2] + p[3]); s += __shfl_xor(s, 16); s += __shfl_xor(s, 32);
                const float rs = __builtin_amdgcn_rsqf(s * (1.0f / DM) + RMS_EPS);
#pragma unroll
                for (int bj = 0; bj < 2; ++bj) { acc[ai][bj][m][0] = acc[ai][bj][m][0] * rs; acc[ai][bj][m][1] = acc[ai][bj][m][1] * rs; } }
        if (fr >= 14) {
#pragma unroll
            for (int ai = 0; ai < 2; ++ai)
#pragma unroll
                for (int bj = 0; bj < 2; ++bj)
#pragma unroll
                    for (int n = 0; n < 2; ++n) { *(PG8_LAS f32x4*)(xl + ((ai * 2 + wr) * 2 + (fr - 14)) * 256 + bj * HALF + tcol + 4 * n) = acc[ai][bj][3][n];
                        if (ai == 1 && wr == 1) *(f32x4*)(halo + (size_t)(u.pm * 2 + (fr - 14)) * NUP + u.pn * BM + bj * HALF + tcol + 4 * n) = acc[1][bj][3][n]; }
        }
        if (fr < 2 && wr == 0) {
#pragma unroll
            for (int bj = 0; bj < 2; ++bj)
#pragma unroll
                for (int n = 0; n < 2; ++n) *(f32x4*)(raw + (size_t)(u.pm * 2 + fr) * NUP + u.pn * BM + bj * HALF + tcol + 4 * n) = acc[0][bj][0][n];
        }
        asm volatile("s_waitcnt lgkmcnt(0)" ::: "memory"); __builtin_amdgcn_s_barrier(); asm volatile("" ::: "memory");
        const int ch = u.pn * HALF + tcol;
#pragma unroll
        for (int n = 0; n < 2; ++n) {
            f32x4 w0[2], w1[2], w2[2], bb[2];
#pragma unroll
            for (int bj = 0; bj < 2; ++bj) { const int c = bj * DFF + ch + 4 * n;
                w0[bj] = *(const f32x4*)(cw + c); w1[bj] = *(const f32x4*)(cw + NUP + c); w2[bj] = *(const f32x4*)(cw + 2 * NUP + c); bb[bj] = *(const f32x4*)(cb + c); }
#pragma unroll
            for (int ai = 0; ai < 2; ++ai) {
                f32x4 hv[2];
                const int src = ai * 2 + wr - 1;
#pragma unroll
                for (int bj = 0; bj < 2; ++bj) { hv[bj] = (f32x4){0.f, 0.f, 0.f, 0.f};
                    if (fr >= 14 && src >= 0) hv[bj] = *(const PG8_LAS f32x4*)(xl + (src * 2 + (fr - 14)) * 256 + bj * HALF + tcol + 4 * n); }
#pragma unroll
                for (int m = 0; m < 4; ++m) { f32x4 cv[2];
#pragma unroll
                    for (int bj = 0; bj < 2; ++bj) { const f32x4 cur = acc[ai][bj][m][n]; const f32x4 prv = (m == 0) ? hv[bj] : acc[ai][bj][m == 0 ? 0 : m - 1][n];
#pragma unroll
                        for (int e = 0; e < 4; ++e) {
                            const float r1 = DPP_F(0.f, prv[e], 0x121), r2 = DPP_F(0.f, prv[e], 0x122);
                            const float p1 = DPP_F(r1, cur[e], 0x111), p2 = DPP_F(r2, cur[e], 0x112);
                            cv[bj][e] = (w0[bj][e] * p2 + w1[bj][e] * p1) + (w2[bj][e] * cur[e] + bb[bj][e]); } }
                    float a[4];
#pragma unroll
                    for (int e = 0; e < 4; ++e) { const float g = cv[0][e]; a[e] = g * sigmoidf_(g) * cv[1][e]; }
                    const bool skip = (ai == 0 && m == 0 && wr == 0 && fr < 2);
                    u32x2 w; w.x = cvt_pk_bf16(a[0], a[1]); w.y = cvt_pk_bf16(a[2], a[3]);
                    if (!skip) *(u32x2*)(ACT + (size_t)(row0 + ai * HALF + m * 16) * DFF + ch + 4 * n) = w; }
            }
        }
    }
};
}
namespace att {
typedef unsigned short bf16_t;
typedef short bf16x8 __attribute__((ext_vector_type(8)));
typedef float f32x4 __attribute__((ext_vector_type(4)));
typedef unsigned u32x4 __attribute__((ext_vector_type(4)));
typedef unsigned u32x2 __attribute__((ext_vector_type(2)));
#define ATT_LAS __attribute__((address_space(3)))
__device__ __forceinline__ f32x4 mfma16(bf16x8 a, bf16x8 b, f32x4 c) { return __builtin_amdgcn_mfma_f32_16x16x32_bf16(a, b, c, 0, 0, 0); }
typedef float f32x2c_t __attribute__((ext_vector_type(2))); typedef __bf16 bf16x2c_t __attribute__((ext_vector_type(2)));
__device__ __forceinline__ unsigned cvtpk(float lo, float hi) { f32x2c_t v = {lo, hi}; bf16x2c_t b = __builtin_convertvector(v, bf16x2c_t); return __builtin_bit_cast(unsigned, b); }
__device__ __forceinline__ int keyperm(int kk, int m) { return 32 * (kk >> 1) + 8 * (m >> 2) + 4 * (kk & 1) + (m & 3); }
__device__ __forceinline__ bf16x8 pack8(const f32x4& a, const f32x4& b) { u32x4 w; w.x = cvtpk(a[0], a[1]); w.y = cvtpk(a[2], a[3]); w.z = cvtpk(b[0], b[1]); w.w = cvtpk(b[2], b[3]); return __builtin_bit_cast(bf16x8, w); }

__device__ __forceinline__ void sb_unit(const bf16_t* QB, const bf16_t* KB, const bf16_t* VT, bf16_t* YB, int b, int h, int qg, int lane) {
    const int fr = lane & 15, fq = lane >> 4;
    const int t = qg * 16 + fr;
    const size_t rb = (size_t)b * SEQ, hb = (size_t)(b * 8 + h) * SEQ;
    const bf16_t* qp = QB + (hb + t) * 64 + 8 * fq;
    const bf16x8 q0 = *(const bf16x8*)qp, q1 = *(const bf16x8*)(qp + 32);
    f32x4 o[4];
#pragma unroll
    for (int d = 0; d < 4; ++d) o[d] = (f32x4){0.f, 0.f, 0.f, 0.f};
    float carry = 0.f;
    const bf16_t* vbase = VT + (size_t)(512 + h * 64 + fr) * VT_PITCH + rb + 8 * fq;
    const int kt0 = (qg * 16 + 15) >> 6;
    bf16x8 kf[8];
#pragma unroll
    for (int kk = 0; kk < 4; ++kk) { const bf16_t* kp = KB + (hb + kt0 * 64 + keyperm(kk, fr)) * 64 + 8 * fq; kf[2 * kk] = *(const bf16x8*)kp; kf[2 * kk + 1] = *(const bf16x8*)(kp + 32); }
    for (int kt = kt0; kt >= 0; --kt) {
        const int k0 = kt * 64;
        bf16x8 vf[8];
#pragma unroll
        for (int dt = 0; dt < 4; ++dt) { const bf16_t* vp = vbase + (size_t)(16 * dt) * VT_PITCH + k0; vf[2 * dt] = *(const bf16x8*)vp; vf[2 * dt + 1] = *(const bf16x8*)(vp + 32); }
        f32x4 s[4];
#pragma unroll
        for (int kk = 0; kk < 4; ++kk) { s[kk] = mfma16(kf[2 * kk], q0, (f32x4){0.f, 0.f, 0.f, 0.f}); s[kk] = mfma16(kf[2 * kk + 1], q1, s[kk]); }
        if (kt > 0) {
#pragma unroll
            for (int kk = 0; kk < 4; ++kk) { const bf16_t* kp = KB + (hb + k0 - 64 + keyperm(kk, fr)) * 64 + 8 * fq; kf[2 * kk] = *(const bf16x8*)kp; kf[2 * kk + 1] = *(const bf16x8*)(kp + 32); }
        }
        float lm[4][4], ls[4][4];
#pragma unroll
        for (int kk = 0; kk < 4; ++kk)
#pragma unroll
            for (int e = 0; e < 4; ++e) { const int key = k0 + 32 * (kk >> 1) + 8 * fq + 4 * (kk & 1) + e; const float z = s[kk][e];
                const float sp = fmaxf(z, 0.f) + __logf(1.0f + __expf(-fabsf(z)));
                const bool ok = key < t; lm[kk][e] = ok ? -sp : 0.f; ls[kk][e] = ok ? (z - sp) : -INFINITY; }
        float tl = 0.f, th = 0.f;
#pragma unroll
        for (int e = 0; e < 4; ++e) { tl += lm[0][e]; th += lm[2][e]; }
#pragma unroll
        for (int e = 0; e < 4; ++e) { tl += lm[1][e]; th += lm[3][e]; }
        float tlj[4], thj[4];
#pragma unroll
        for (int j = 0; j < 4; ++j) { tlj[j] = __shfl(tl, fr + 16 * j); thj[j] = __shfl(th, fr + 16 * j); }
        const float TH = (thj[0] + thj[1]) + (thj[2] + thj[3]), TL = (tlj[0] + tlj[1]) + (tlj[2] + tlj[3]);
        float ah = carry, al = carry + TH;
#pragma unroll
        for (int j = 3; j >= 1; --j) { if (fq < j) { ah += thj[j]; al += tlj[j]; } }
        f32x4 a[4];
        float run = ah;
#pragma unroll
        for (int kk = 3; kk >= 2; --kk)
#pragma unroll
            for (int e = 3; e >= 0; --e) { a[kk][e] = __expf(ls[kk][e] + run); run += lm[kk][e]; }
        run = al;
#pragma unroll
        for (int kk = 1; kk >= 0; --kk)
#pragma unroll
            for (int e = 3; e >= 0; --e) { a[kk][e] = __expf(ls[kk][e] + run); run += lm[kk][e]; }
        carry += TH + TL;
        const bf16x8 p0 = pack8(a[0], a[1]), p1 = pack8(a[2], a[3]);
#pragma unroll
        for (int dt = 0; dt < 4; ++dt) { o[dt] = mfma16(vf[2 * dt], p0, o[dt]); o[dt] = mfma16(vf[2 * dt + 1], p1, o[dt]); }
        if (__all(carry < -110.0f)) break;
    }
    bf16_t* yp = YB + (rb + t) * 512 + h * 64 + 4 * fq;
#pragma unroll
    for (int dt = 0; dt < 4; ++dt) { u32x2 w; w.x = cvtpk(o[dt][0], o[dt][1]); w.y = cvtpk(o[dt][2], o[dt][3]); *(u32x2*)(yp + 16 * dt) = w; }
}

__device__ __forceinline__ void moba_item(const bf16_t* QA, size_t hb, int i, int qidx, bool causal, bool first, ATT_LAS const unsigned char* kl, ATT_LAS const unsigned char* vl,
                                          ATT_LAS float* st_m, ATT_LAS float* st_l, ATT_LAS float* st_o, int lane) {
    const int fr = lane & 15, fq = lane >> 4;
    const bool valid = qidx >= 0; const int q = valid ? qidx : 0;
    const bf16_t* qp = QA + (hb + 256 * i + q) * 64 + 8 * fq;
    const bf16x8 q0 = *(const bf16x8*)qp, q1 = *(const bf16x8*)(qp + 32);
    ATT_LAS const unsigned char* kp = kl + fr * 144 + 16 * fq;
    f32x4 s[16];
#pragma unroll
    for (int kk = 0; kk < 16; ++kk) { const bf16x8 a0 = *(ATT_LAS const bf16x8*)(kp + kk * 16 * 144), a1 = *(ATT_LAS const bf16x8*)(kp + kk * 16 * 144 + 64);
        s[kk] = mfma16(a0, q0, (f32x4){0.f, 0.f, 0.f, 0.f}); s[kk] = mfma16(a1, q1, s[kk]); }
    if (causal) {
#pragma unroll
        for (int kk = 0; kk < 16; ++kk)
#pragma unroll
            for (int e = 0; e < 4; ++e) { const int key = 32 * (kk >> 1) + 8 * fq + 4 * (kk & 1) + e; if (key > q) s[kk][e] = -INFINITY; }
    }
    float mb = -INFINITY;
#pragma unroll
    for (int kk = 0; kk < 16; ++kk) mb = fmaxf(mb, fmaxf(fmaxf(s[kk][0], s[kk][1]), fmaxf(s[kk][2], s[kk][3])));
    mb = fmaxf(mb, __shfl_xor(mb, 16)); mb = fmaxf(mb, __shfl_xor(mb, 32));
    float lb = 0.f;
#pragma unroll
    for (int kk = 0; kk < 16; ++kk)
#pragma unroll
        for (int e = 0; e < 4; ++e) { const float p = __builtin_amdgcn_exp2f(s[kk][e] - mb); s[kk][e] = p; lb += p; }
    lb += __shfl_xor(lb, 16); lb += __shfl_xor(lb, 32);
    f32x4 o[4];
#pragma unroll
    for (int d = 0; d < 4; ++d) o[d] = (f32x4){0.f, 0.f, 0.f, 0.f};
    ATT_LAS const unsigned char* vp = vl + fr * 528 + 16 * fq;
#pragma unroll
    for (int ks = 0; ks < 8; ++ks) { const bf16x8 p = pack8(s[2 * ks], s[2 * ks + 1]);
#pragma unroll
        for (int dt = 0; dt < 4; ++dt) { const bf16x8 v = *(ATT_LAS const bf16x8*)(vp + dt * 16 * 528 + 64 * ks); o[dt] = mfma16(v, p, o[dt]); } }
    if (valid) {
        ATT_LAS float* so = st_o + q * 68 + 4 * fq;
        if (first) {
            if (fq == 0) { st_m[q] = mb; st_l[q] = lb; }
#pragma unroll
            for (int dt = 0; dt < 4; ++dt) *(ATT_LAS f32x4*)(so + 16 * dt) = o[dt];
        } else {
            const float mo = st_m[q], lo = st_l[q]; const float mn = fmaxf(mo, mb);
            const float ca = __builtin_amdgcn_exp2f(mo - mn), cb2 = __builtin_amdgcn_exp2f(mb - mn);
            f32x4 oo[4];
#pragma unroll
            for (int dt = 0; dt < 4; ++dt) oo[dt] = *(const ATT_LAS f32x4*)(so + 16 * dt);
#pragma unroll
            for (int dt = 0; dt < 4; ++dt) *(ATT_LAS f32x4*)(so + 16 * dt) = oo[dt] * ca + o[dt] * cb2;
            if (fq == 0) { st_m[q] = mn; st_l[q] = lo * ca + lb * cb2; }
        }
    }
}

constexpr int L_KS = 0;
constexpr int L_VS = 36864;
constexpr int L_KM = 0;
constexpr int L_CAND = 8192;
constexpr int L_CNT = 70656;
constexpr int L_LIST = 70784;
constexpr int L_STM = 78976;
constexpr int L_STL = 80000;
constexpr int L_STO = 81024;

__device__ __forceinline__ void wg_bar() { asm volatile("s_waitcnt vmcnt(0) lgkmcnt(0)" ::: "memory"); __builtin_amdgcn_s_barrier(); asm volatile("" ::: "memory"); }
__device__ __forceinline__ void wg_bar_lds() { asm volatile("s_waitcnt lgkmcnt(0)" ::: "memory"); __builtin_amdgcn_s_barrier(); asm volatile("" ::: "memory"); }

__device__ __forceinline__ void moba_unit(ATT_LAS unsigned char* lds, const bf16_t* QA, const bf16_t* KA, const bf16_t* VT, const float* KMP, bf16_t* YA, int b, int h, int i) {
    int tid_ = threadIdx.x; asm volatile("" : "+v"(tid_));
    const int tid = tid_, lane = tid & 63, wid = __builtin_amdgcn_readfirstlane(tid >> 6);
    ATT_LAS float* km = (ATT_LAS float*)(lds + L_KM);
    ATT_LAS float* candv = (ATT_LAS float*)(lds + L_CAND); ATT_LAS int* candi = (ATT_LAS int*)(lds + L_CAND + 6144);
    ATT_LAS int* cnt = (ATT_LAS int*)(lds + L_CNT);
    ATT_LAS unsigned char* list = (ATT_LAS unsigned char*)(lds + L_LIST);
    ATT_LAS float* st_m = (ATT_LAS float*)(lds + L_STM); ATT_LAS float* st_l = (ATT_LAS float*)(lds + L_STL); ATT_LAS float* st_o = (ATT_LAS float*)(lds + L_STO);
    const size_t rb = (size_t)b * SEQ, hb = (size_t)(b * 8 + h) * SEQ;
    const bf16_t* kg = KA + (hb + (tid >> 3)) * 64 + (tid & 7) * 8;
    const bf16_t* vg = VT + (size_t)(h * 64 + (tid >> 5)) * VT_PITCH + rb + (tid & 31) * 8;
    u32x4 kr[4], vr[4];
#define MOBA_PREFETCH(j_) do { _Pragma("unroll") for (int c = 0; c < 4; ++c) { kr[c] = *(const u32x4*)(kg + (size_t)(256 * (j_) + 64 * c) * 64); vr[c] = *(const u32x4*)(vg + (size_t)(16 * c) * VT_PITCH + 256 * (j_)); } } while (0)
#define MOBA_STAGE() do { _Pragma("unroll") for (int c = 0; c < 4; ++c) { const int row = (tid >> 3) + 64 * c; const int rho = 16 * (2 * (row >> 5) + ((row >> 2) & 1)) + 4 * ((row >> 3) & 3) + (row & 3); \
        *(ATT_LAS u32x4*)(lds + L_KS + rho * 144 + (tid & 7) * 16) = kr[c]; *(ATT_LAS u32x4*)(lds + L_VS + ((tid >> 5) + 16 * c) * 528 + (tid & 31) * 16) = vr[c]; } } while (0)
    wg_bar();
    MOBA_PREFETCH(i);
    for (int idx = tid; idx < i * 64; idx += 512) { const int j = idx >> 6, d = idx & 63; const float* p = KMP + (size_t)((b * 32 + j) * 2) * 512 + h * 64 + d; km[idx] = (p[0] + p[512]) * (1.0f / 256.0f); }
    if (tid < 32) cnt[tid] = 0;
    wg_bar_lds();
    {
        const int q = tid & 255, half = tid >> 8;
        const bf16_t* qp = QA + (hb + 256 * i + q) * 64;
        float qf[64];
#pragma unroll
        for (int c = 0; c < 8; ++c) { const u32x4 w = *(const u32x4*)(qp + 8 * c);
            qf[8 * c + 0] = __uint_as_float(w.x << 16); qf[8 * c + 1] = __uint_as_float(w.x & 0xffff0000u); qf[8 * c + 2] = __uint_as_float(w.y << 16); qf[8 * c + 3] = __uint_as_float(w.y & 0xffff0000u);
            qf[8 * c + 4] = __uint_as_float(w.z << 16); qf[8 * c + 5] = __uint_as_float(w.z & 0xffff0000u); qf[8 * c + 6] = __uint_as_float(w.w << 16); qf[8 * c + 7] = __uint_as_float(w.w & 0xffff0000u); }
        float v0 = -INFINITY, v1 = -INFINITY, v2 = -INFINITY; int i0 = -1, i1 = -1, i2 = -1;
        const int jlo = 16 * half, jhi = (i < jlo + 16) ? i : jlo + 16;
        for (int j = jlo; j < jhi; ++j) {
            const ATT_LAS f32x4* kr_ = (const ATT_LAS f32x4*)(km + j * 64);
            float g0 = 0.f, g1 = 0.f, g2 = 0.f, g3 = 0.f;
#pragma unroll
            for (int c = 0; c < 16; ++c) { const f32x4 kv = kr_[c]; g0 = fmaf(qf[4 * c], kv[0], g0); g1 = fmaf(qf[4 * c + 1], kv[1], g1); g2 = fmaf(qf[4 * c + 2], kv[2], g2); g3 = fmaf(qf[4 * c + 3], kv[3], g3); }
            const float g = (g0 + g1) + (g2 + g3);
            if (g > v0) { v2 = v1; i2 = i1; v1 = v0; i1 = i0; v0 = g; i0 = j; }
            else if (g > v1) { v2 = v1; i2 = i1; v1 = g; i1 = j; }
            else if (g > v2) { v2 = g; i2 = j; }
        }
        const int cb = (half * 256 + q) * 3;
        candv[cb] = v0; candv[cb + 1] = v1; candv[cb + 2] = v2; candi[cb] = i0; candi[cb + 1] = i1; candi[cb + 2] = i2;
    }
    wg_bar_lds();
    if (tid < 256) {
        const int q = tid; float av[3], bv[3]; int ax[3], bx[3];
#pragma unroll
        for (int r = 0; r < 3; ++r) { av[r] = candv[q * 3 + r]; ax[r] = candi[q * 3 + r]; bv[r] = candv[(256 + q) * 3 + r]; bx[r] = candi[(256 + q) * 3 + r]; }
        int pa = 0, pb = 0;
#pragma unroll
        for (int r = 0; r < 3; ++r) {
            const float va = pa == 0 ? av[0] : pa == 1 ? av[1] : pa == 2 ? av[2] : -INFINITY; const int xa = pa == 0 ? ax[0] : pa == 1 ? ax[1] : pa == 2 ? ax[2] : -1;
            const float vb = pb == 0 ? bv[0] : pb == 1 ? bv[1] : pb == 2 ? bv[2] : -INFINITY; const int xb = pb == 0 ? bx[0] : pb == 1 ? bx[1] : pb == 2 ? bx[2] : -1;
            int pick;
            if (xa >= 0 && (xb < 0 || va >= vb)) { pick = xa; ++pa; } else if (xb >= 0) { pick = xb; ++pb; } else pick = -1;
            if (pick >= 0) { const int slot = __hip_atomic_fetch_add(&cnt[pick], 1, __ATOMIC_RELAXED, __HIP_MEMORY_SCOPE_WORKGROUP); list[pick * 256 + slot] = (unsigned char)q; }
        }
    }
    wg_bar();
    MOBA_STAGE();
    wg_bar_lds();
    for (int step = 0; step <= i; ++step) {
        const bool more = step < i;
        if (more) MOBA_PREFETCH(step);
        const int j = step - 1;
        const int n = (step == 0) ? 256 : cnt[j];
        const int nit = __builtin_amdgcn_readfirstlane((n + 15) >> 4);
        for (int k = wid; k < nit; k += 8) {
            const int pos = 16 * k + (lane & 15);
            const int qidx = (step == 0) ? pos : (pos < n ? (int)list[j * 256 + pos] : -1);
            moba_item(QA, hb, i, qidx, step == 0, step == 0, lds + L_KS, lds + L_VS, st_m, st_l, st_o, lane);
        }
        wg_bar();
        if (more) { MOBA_STAGE(); wg_bar_lds(); }
    }
#undef MOBA_PREFETCH
#undef MOBA_STAGE
    { const int q = tid >> 1, hf = tid & 1; const float rl = 1.0f / st_l[q]; const ATT_LAS float* so = st_o + q * 68 + 32 * hf;
      bf16_t* yp = YA + (rb + 256 * i + q) * 512 + h * 64 + 32 * hf;
#pragma unroll
      for (int c = 0; c < 4; ++c) { const f32x4 a = *(const ATT_LAS f32x4*)(so + 8 * c) * rl, bq = *(const ATT_LAS f32x4*)(so + 8 * c + 4) * rl;
          u32x4 w; w.x = cvtpk(a[0], a[1]); w.y = cvtpk(a[2], a[3]); w.z = cvtpk(bq[0], bq[1]); w.w = cvtpk(bq[2], bq[3]); *(u32x4*)(yp + 8 * c) = w; } }
}
}
#define LAS __attribute__((address_space(3)))
typedef unsigned short bf16;
typedef unsigned v4u __attribute__((ext_vector_type(4)));
typedef float f32x4 __attribute__((ext_vector_type(4)));
typedef __attribute__((address_space(1))) unsigned gu32;
constexpr int NWAVES = 8;
constexpr int RING_BYTES = 131072, EXCH_OFF = RING_BYTES, LDS_BYTES = 163840;
__device__ __forceinline__ unsigned f2bf(float f) { unsigned u = __builtin_bit_cast(unsigned, f); return (u + 0x7fffu + ((u >> 16) & 1u)) >> 16; }
__device__ __forceinline__ unsigned pk2(float lo, float hi) { return f2bf(lo) | (f2bf(hi) << 16); }
__device__ __forceinline__ float wave_sum(float v) {
#pragma unroll
    for (int o = 1; o < 64; o <<= 1) v += __shfl_xor(v, o);
    return v;
}
#define XB_TMO      128
#define XB_XCNT(j)  (256  + 64 * (j))
#define XB_XSUB(j)  (1280 + 64 * (j))
#define XB_XGEN(j)  (2304 + 64 * (j))
#define XB_TOP      3328
#define XB_TOPGEN   3392
#define XCD_BAR_WORDS 3456
#define XB_SPIN_CAP (1u << 18)

__device__ __forceinline__ unsigned xb_ld(unsigned* p)              { return __hip_atomic_load(p, __ATOMIC_RELAXED, __HIP_MEMORY_SCOPE_AGENT); }
__device__ __forceinline__ unsigned xb_add(unsigned* p, unsigned v) { return __hip_atomic_fetch_add(p, v, __ATOMIC_RELAXED, __HIP_MEMORY_SCOPE_AGENT); }
__device__ __forceinline__ unsigned xb_xcc_id() { return (unsigned)__builtin_amdgcn_s_getreg((3 << 11) | 20) & 0xFu; }
#define XB_SPIN(cond, bar) do { unsigned _sp = 0; while (cond) { __builtin_amdgcn_s_sleep(1); \
    if ((++_sp & 255u) == 0u) { if (xb_ld(&(bar)[XB_TMO])) break; if (_sp > XB_SPIN_CAP) { atomicAdd(&(bar)[XB_TMO], 1u); break; } } } } while (0)

struct XcdBarrier {
    unsigned* bar; unsigned x;
    volatile LAS unsigned* st;
};

__device__ __forceinline__ XcdBarrier xcd_barrier_post(unsigned* bar, volatile LAS unsigned* st) {
    XcdBarrier b; b.bar = bar; b.x = xb_xcc_id(); b.st = st;
    if (threadIdx.x == 0) (void)xb_add(&bar[XB_XCNT(b.x)], 1u);
    return b;
}
__device__ __forceinline__ void xcd_barrier_complete(unsigned* bar, unsigned x, unsigned& nloc, unsigned& nx) {
    const unsigned G = gridDim.x * gridDim.y * gridDim.z;
    unsigned sum, cnt, mine, sp = 0u;
    for (;;) {
        sum = 0u; cnt = 0u; mine = 0u;
#pragma unroll
        for (unsigned j = 0; j < 16; ++j) { const unsigned c = xb_ld(&bar[XB_XCNT(j)]); sum += c; cnt += (c > 0u) ? 1u : 0u; mine = (j == x) ? c : mine; }
        if (sum == G) break;
        __builtin_amdgcn_s_sleep(1);
        if ((++sp & 255u) == 0u) { if (xb_ld(&bar[XB_TMO])) break; if (sp > XB_SPIN_CAP) { atomicAdd(&bar[XB_TMO], 1u); break; } }
    }
    nloc = mine > 0u ? mine : 1u; nx = cnt > 0u ? cnt : 1u;
}

__device__ __forceinline__ void xcd_barrier(const XcdBarrier& b) {
    asm volatile("s_waitcnt vmcnt(0)" ::: "memory");
    __syncthreads();
    if (threadIdx.x == 0) {
        unsigned* bar = b.bar;
        __builtin_amdgcn_s_waitcnt(0);
        unsigned nloc = b.st[0], nx = b.st[1];
        if (nloc == 0u) { xcd_barrier_complete(bar, b.x, nloc, nx); b.st[0] = nloc; b.st[1] = nx; }
        const unsigned old = xb_add(&bar[XB_XSUB(b.x)], 1u);
        const unsigned gen = old / nloc;
        if (old + 1u == (gen + 1u) * nloc) {
            __builtin_amdgcn_fence(__ATOMIC_RELEASE, "agent");
            asm volatile("s_waitcnt vmcnt(0)" ::: "memory");
            const unsigned og = xb_add(&bar[XB_TOP], 1u);
            const unsigned tg = og / nx;
            if (og + 1u == (tg + 1u) * nx) xb_add(&bar[XB_TOPGEN], 1u);
            else XB_SPIN(xb_ld(&bar[XB_TOPGEN]) == tg, bar);
            __builtin_amdgcn_fence(__ATOMIC_ACQUIRE, "agent");
            xb_add(&bar[XB_XGEN(b.x)], 1u);
            asm volatile("s_waitcnt vmcnt(0)" ::: "memory");
        } else {
            XB_SPIN(xb_ld(&bar[XB_XGEN(b.x)]) == gen, bar);
            __builtin_amdgcn_fence(__ATOMIC_ACQUIRE, "agent");
            asm volatile("s_waitcnt vmcnt(0)" ::: "memory");
        }
    }
    __syncthreads();
}

constexpr size_t WS_CTL = 40 * MiB + 768 * 1024;
__device__ __forceinline__ int map_win(int c) {
    if (c < 1024) { const int reg = c >> 9, cc = c & 511, head = cc >> 6, d = cc & 63; const int pp = 8 * ((d >> 2) & 7) + 4 * (d >> 5) + (d & 3); return reg * 512 + head * 64 + pp; }
    if (c < 1536) return 4096 + (c - 1024);
    if (c < 2048) return 1024 + (c - 1536);
    if (c < 2560) return 1536 + (c - 2048);
    if (c < 3072) return 4608 + (c - 2560);
    return 2048 + (c - 3072);
}
__device__ __forceinline__ int map_wup(int c) { const int v = c >= DFF ? 1 : 0, cc = c - v * DFF; return 256 * (cc >> 7) + 128 * v + (cc & 127); }
template <int MAP> __device__ __forceinline__ void transpose_item(const float* W, int K, int N, bf16* WT, const float* kscale, LAS float* scr, int item, int lane) {
    const int nblk = N / 32, kb = item / nblk, nb = item % nblk, k0 = 64 * kb, n0 = 32 * nb;
#pragma unroll 8
    for (int i = 0; i < 32; ++i) { const int kk = 2 * i + (lane >> 5); float v = W[(size_t)(k0 + kk) * N + n0 + (lane & 31)]; if (kscale) v *= kscale[k0 + kk]; scr[kk * 33 + (lane & 31)] = v; }
    asm volatile("s_waitcnt lgkmcnt(0)" ::: "memory");
    const int c = lane & 7;
#pragma unroll
    for (int j = 0; j < 4; ++j) { const int n = (lane >> 3) + 8 * j; const LAS float* s = scr + (8 * c) * 33 + n;
        v4u o; o.x = pk2(s[0 * 33], s[1 * 33]); o.y = pk2(s[2 * 33], s[3 * 33]); o.z = pk2(s[4 * 33], s[5 * 33]); o.w = pk2(s[6 * 33], s[7 * 33]);
        const int sc = n0 + n; const int row = MAP == 1 ? map_win(sc) : MAP == 2 ? map_wup(sc) : sc;
        *(v4u*)(WT + (size_t)row * K + k0 + 8 * c) = o; }
    asm volatile("s_waitcnt lgkmcnt(0)" ::: "memory");
}
__device__ __forceinline__ void rms_row_bf16(const float* xrow, const float* g, bf16* orow, int lane) {
    const f32x4* xr = (const f32x4*)xrow + lane; const f32x4* gr = (const f32x4*)g + lane;
    f32x4 v[4]; float s = 0.f;
#pragma unroll
    for (int j = 0; j < 4; ++j) { v[j] = xr[64 * j]; s += (v[j][0] * v[j][0] + v[j][1] * v[j][1]) + (v[j][2] * v[j][2] + v[j][3] * v[j][3]); }
    const float rstd = 1.0f / sqrtf(wave_sum(s) * (1.0f / DM) + RMS_EPS);
    unsigned long long* o8 = (unsigned long long*)orow + lane;
#pragma unroll
    for (int j = 0; j < 4; ++j) { const f32x4 gg = gr[64 * j]; o8[64 * j] = (unsigned long long)pk2(v[j][0] * rstd * gg[0], v[j][1] * rstd * gg[1]) | ((unsigned long long)pk2(v[j][2] * rstd * gg[2], v[j][3] * rstd * gg[3]) << 32); }
}
__device__ __forceinline__ void rms_rows4_bf16(const float* x0, const float* g, bf16* o0, int lane) {
    f32x4 v[4][4]; float s[4];
#pragma unroll
    for (int r = 0; r < 4; ++r) { const f32x4* xr = (const f32x4*)(x0 + (size_t)r * DM) + lane; s[r] = 0.f;
#pragma unroll
        for (int j = 0; j < 4; ++j) { v[r][j] = xr[64 * j]; } }
#pragma unroll
    for (int r = 0; r < 4; ++r)
#pragma unroll
        for (int j = 0; j < 4; ++j) s[r] += (v[r][j][0] * v[r][j][0] + v[r][j][1] * v[r][j][1]) + (v[r][j][2] * v[r][j][2] + v[r][j][3] * v[r][j][3]);
    const f32x4* gr = (const f32x4*)g + lane;
#pragma unroll
    for (int r = 0; r < 4; ++r) { const float rstd = 1.0f / sqrtf(wave_sum(s[r]) * (1.0f / DM) + RMS_EPS); unsigned long long* o8 = (unsigned long long*)(o0 + (size_t)r * DM) + lane;
#pragma unroll
        for (int j = 0; j < 4; ++j) { const f32x4 gg = gr[64 * j]; o8[64 * j] = (unsigned long long)pk2(v[r][j][0] * rstd * gg[0], v[r][j][1] * rstd * gg[1]) | ((unsigned long long)pk2(v[r][j][2] * rstd * gg[2], v[r][j][3] * rstd * gg[3]) << 32); } }
}
__device__ __forceinline__ void rms_rows4_f32(float* x0, const float* g, int lane) {
    f32x4 v[4][4]; float s[4];
#pragma unroll
    for (int r = 0; r < 4; ++r) { const f32x4* xr = (const f32x4*)(x0 + (size_t)r * DM) + lane; s[r] = 0.f;
#pragma unroll
        for (int j = 0; j < 4; ++j) { v[r][j] = xr[64 * j]; } }
#pragma unroll
    for (int r = 0; r < 4; ++r)
#pragma unroll
        for (int j = 0; j < 4; ++j) s[r] += (v[r][j][0] * v[r][j][0] + v[r][j][1] * v[r][j][1]) + (v[r][j][2] * v[r][j][2] + v[r][j][3] * v[r][j][3]);
    const f32x4* gr = (const f32x4*)g + lane;
#pragma unroll
    for (int r = 0; r < 4; ++r) { const float rstd = 1.0f / sqrtf(wave_sum(s[r]) * (1.0f / DM) + RMS_EPS); f32x4* xr = (f32x4*)(x0 + (size_t)r * DM) + lane;
#pragma unroll
        for (int j = 0; j < 4; ++j) xr[64 * j] = v[r][j] * rstd * gr[64 * j]; }
}
__device__ __forceinline__ void rms_row_f32(float* xrow, const float* g, int lane) {
    f32x4* xr = (f32x4*)xrow + lane; const f32x4* gr = (const f32x4*)g + lane;
    f32x4 v[4]; float s = 0.f;
#pragma unroll
    for (int j = 0; j < 4; ++j) { v[j] = xr[64 * j]; s += (v[j][0] * v[j][0] + v[j][1] * v[j][1]) + (v[j][2] * v[j][2] + v[j][3] * v[j][3]); }
    const float rstd = 1.0f / sqrtf(wave_sum(s) * (1.0f / DM) + RMS_EPS);
#pragma unroll
    for (int j = 0; j < 4; ++j) xr[64 * j] = v[j] * rstd * gr[64 * j];
}

#ifndef DUP_MASK
#define DUP_MASK 0
#endif
#define TPROBE_BEGIN(bit) do { if ((DUP_MASK >> (bit)) & 1) { if (lane == 0) *(volatile LAS unsigned long long*)(lds + 163000 + wave * 8) = __builtin_amdgcn_s_memrealtime(); } } while (0)
#define TPROBE_END(bit) do { if ((DUP_MASK >> (bit)) & 1) { asm volatile("s_waitcnt vmcnt(0) lgkmcnt(0)" ::: "memory"); const unsigned long long t1_ = __builtin_amdgcn_s_memrealtime(); const unsigned long long t0_ = *(volatile LAS unsigned long long*)(lds + 163000 + (tid >> 6) * 8); \
    const unsigned long long d_ = __builtin_amdgcn_readfirstlane((unsigned)(t1_ - t0_)); while (__builtin_amdgcn_s_memrealtime() - t1_ < d_) __builtin_amdgcn_s_sleep(16); } } while (0)
struct Args { const float* in[13]; float* out; unsigned char* ws; };

__global__ void __launch_bounds__(NWAVES * 64, 2) mega_fwd(Args args) {
    extern __shared__ __attribute__((aligned(16))) unsigned char lds_raw[];
    cg::grid_group grid = cg::this_grid();
    LAS unsigned char* lds = (LAS unsigned char*)lds_raw;
    const int tid = threadIdx.x, lane = tid & 63, wave = __builtin_amdgcn_readfirstlane(tid >> 6);
    const int G = gridDim.x, bx = blockIdx.x;
    volatile LAS unsigned* MISC = (volatile LAS unsigned*)(lds + 163200);
    if (tid < 8) MISC[tid] = 0u;
    __syncthreads();
    const float* x = args.in[0]; const float* g_mix = args.in[1]; const float* w_in = args.in[2]; const float* b_gate = args.in[3];
    const float* w_a = args.in[4]; const float* w_b = args.in[5]; const float* w_out = args.in[6]; const float* g_ffn = args.in[7];
    const float* w_up = args.in[8]; const float* conv_w = args.in[9]; const float* conv_b = args.in[10]; const float* w_down = args.in[11]; const float* g_final = args.in[12];
    float* out = args.out; unsigned char* ws = args.ws;
    bf16 *Win = (bf16*)(ws + WS_WIN), *Wa = (bf16*)(ws + WS_WA), *Wb = (bf16*)(ws + WS_WB), *Wout = (bf16*)(ws + WS_WOUT), *Wup = (bf16*)(ws + WS_WUP), *Wdn = (bf16*)(ws + WS_WDN);
    float *CS = (float*)(ws + WS_CS), *KMP = (float*)(ws + WS_KMP), *SSQ = (float*)(ws + WS_SSQ), *HALO = (float*)(ws + WS_HALO), *RAW = (float*)(ws + WS_RAW);
    bf16 *XN = (bf16*)(ws + WS_XN), *QA = (bf16*)(ws + WS_QA), *KA = (bf16*)(ws + WS_KA), *QB = (bf16*)(ws + WS_QB), *KB = (bf16*)(ws + WS_KB), *VT = (bf16*)(ws + WS_VT), *GT = (bf16*)(ws + WS_G);
    bf16 *YA = (bf16*)(ws + WS_YA), *YB = (bf16*)(ws + WS_YB), *MRG = (bf16*)(ws + WS_MRG), *X1B = (bf16*)(ws + WS_X1B), *ACT = (bf16*)(ws + WS_ACT);

    {
        LAS float* scr = (LAS float*)(lds + wave * 16384);
        const int gw = bx * NWAVES + wave, NGW = G * NWAVES;
        constexpr int I_IN = (DM / 64) * (5120 / 32), I_A = (512 / 64) * (DM / 32), I_O = (DM / 64) * (DM / 32), I_UP = (DM / 64) * (NUP / 32), I_DN = (DFF / 64) * (DM / 32);
        constexpr int NITEMS = I_IN + 2 * I_A + I_O + I_UP + I_DN;
        for (int it = gw; it < NITEMS; it += NGW) {
            int r = it;
            if (r < I_IN) { transpose_item<1>(w_in, DM, 5120, Win, nullptr, scr, r, lane); continue; } r -= I_IN;
            if (r < I_A) { transpose_item<0>(w_a, 512, DM, Wa, nullptr, scr, r, lane); continue; } r -= I_A;
            if (r < I_A) { transpose_item<0>(w_b, 512, DM, Wb, nullptr, scr, r, lane); continue; } r -= I_A;
            if (r < I_O) { transpose_item<0>(w_out, DM, DM, Wout, nullptr, scr, r, lane); continue; } r -= I_O;
            if (r < I_UP) { transpose_item<2>(w_up, DM, NUP, Wup, g_ffn, scr, r, lane); continue; } r -= I_UP;
            transpose_item<0>(w_down, DFF, DM, Wdn, nullptr, scr, r, lane);
        }
        for (int m = gw * 4; m < M_TOK; m += NGW * 4) rms_rows4_bf16(x + (size_t)m * DM, g_mix, XN + (size_t)m * DM, lane);
        if (bx == 0) { unsigned* bw = (unsigned*)(ws + WS_CTL); for (int k_ = tid; k_ < XCD_BAR_WORDS; k_ += 512) bw[k_] = 0u; }
        for (int e = bx * 512 + tid; e < SEQ * 32; e += G * 512) { const int pos = e >> 5, fi = e & 31;
            double inv = 1.0; for (int k = 0; k < fi; ++k) inv *= 0.7498942093324558;
            const float ang = (float)pos * (float)inv; const double rv = (double)ang * 0.15915494309189535; const float fr_ = (float)(rv - __builtin_rint(rv));
            CS[(size_t)pos * 64 + fi] = __builtin_amdgcn_cosf(fr_); CS[(size_t)pos * 64 + 32 + fi] = __builtin_amdgcn_sinf(fr_); }
    }
    grid.sync();
    XcdBarrier bar = xcd_barrier_post((unsigned*)(ws + WS_CTL), MISC);
    {
        pg8::Gemm g{XN, Win, M_TOK, 4096, DM}; pg8::StaticOrder S; S.init(M_TOK, 4096, G, bx);
        pg8::EpiInProj E{QA, KA, QB, KB, GT, b_gate, CS, KMP};
        pg8::gemm_phase<pg8::EpiInProj, pg8::StaticOrder, true, true>(lds, g, S, E);
        pg8::Gemm g2{Win + (size_t)4096 * DM, XN, 1024, M_TOK, DM}; pg8::StaticOrder S2; S2.init(1024, M_TOK, G, bx);
        pg8::EpiPlain E2{VT, VT_PITCH, 1.0f};
        pg8::gemm_phase<pg8::EpiPlain, pg8::StaticOrder, true, true>(lds, g2, S2, E2);
    }
    xcd_barrier(bar);
    {
        const int vcu = (G % 8 == 0) ? (bx % 8) * (G / 8) + bx / 8 : bx;
        for (int n = vcu; n < 512; n += G) { const int c = n & 255, rnd = n >> 8; const int bh = (c >> 5) + 8 * rnd, l = c & 31; const int i = rnd ? 31 - l : l;
            att::moba_unit(lds, QA, KA, VT, KMP, YA, bh >> 3, bh & 7, i); }
        const int gw = vcu * NWAVES + wave, NGW = G * NWAVES;
        for (int un = gw; un < 8192; un += NGW) { const int bh = un >> 9, qg = un & 511; att::sb_unit(QB, KB, VT, YB, bh >> 3, bh & 7, qg, lane); }
    }
    xcd_barrier(bar);
    {
        pg8::Gemm g{YA, Wa, M_TOK, DM, 512}; pg8::StaticOrder S; S.init(M_TOK, DM, G, bx);
        pg8::EpiBranch<0> E{MRG, GT};
        pg8::gemm_phase<pg8::EpiBranch<0>, pg8::StaticOrder, true, true>(lds, g, S, E);
        pg8::Gemm g2{YB, Wb, M_TOK, DM, 512};
        pg8::EpiBranch<1> E2{MRG, GT};
        pg8::gemm_phase<pg8::EpiBranch<1>, pg8::StaticOrder, true, true>(lds, g2, S, E2);
    }
    xcd_barrier(bar);
    {
        pg8::Gemm g{MRG, Wout, M_TOK, DM, DM}; pg8::StaticOrder S; S.init(M_TOK, DM, G, bx);
        pg8::EpiResid<true> E{x, out, X1B, SSQ};
        pg8::gemm_phase<pg8::EpiResid<true>, pg8::StaticOrder, true, true>(lds, g, S, E);
    }
    xcd_barrier(bar);
    TPROBE_BEGIN(6);
    {
        pg8::Gemm g{X1B, Wup, M_TOK, NUP, DM}; pg8::StaticOrder S; S.init(M_TOK, NUP, G, bx);
        pg8::EpiUp E{ACT, SSQ, conv_w, conv_b, HALO, RAW, (LAS float*)(lds + EXCH_OFF)};
        pg8::gemm_phase<pg8::EpiUp, pg8::StaticOrder, true, true>(lds, g, S, E);
    }
    TPROBE_END(6);
    if ((DUP_MASK >> 12) & 1) { for (int k_ = 0; k_ < 6; ++k_) xcd_barrier(bar); }
    xcd_barrier(bar);
    TPROBE_BEGIN(7);
    {
        pg8::StaticOrder S; S.init(M_TOK, DM, G, bx); pg8::Unit u;
        for (int ui = 0; S.next(ui, u); ++ui) {
            const int pm = u.pm; const bool hasprev = (pm & 31) != 0;
            for (int idx = tid; idx < 2 * DFF; idx += 512) { const int r = idx >= DFF ? 1 : 0, c = idx - r * DFF; const int gc = 256 * (c >> 7) + (c & 127);
                float a2[2];
#pragma unroll
                for (int v = 0; v < 2; ++v) { const int tc = gc + 128 * v, cc = c + v * DFF;
                    const float h0 = hasprev ? HALO[(size_t)((pm - 1) * 2 + 0) * NUP + tc] : 0.f, h1 = hasprev ? HALO[(size_t)((pm - 1) * 2 + 1) * NUP + tc] : 0.f;
                    const float r0 = RAW[(size_t)(pm * 2 + 0) * NUP + tc], r1 = RAW[(size_t)(pm * 2 + 1) * NUP + tc];
                    const float cur = r ? r1 : r0, p1 = r ? r0 : h1, p2 = r ? h1 : h0;
                    a2[v] = (conv_w[cc] * p2 + conv_w[NUP + cc] * p1) + (conv_w[2 * NUP + cc] * cur + conv_b[cc]); }
                const float act = a2[0] * pg8::sigmoidf_(a2[0]) * a2[1];
                ACT[(size_t)(pm * 256 + r) * DFF + c] = (bf16)f2bf(act); }
        }
        __threadfence(); __syncthreads(); __builtin_amdgcn_fence(__ATOMIC_ACQUIRE, "agent"); asm volatile("s_waitcnt vmcnt(0)" ::: "memory"); __syncthreads();
        pg8::Gemm g{ACT, Wdn, M_TOK, DM, DFF};
        pg8::EpiResid<false> E{out, out, nullptr, nullptr};
        pg8::gemm_phase<pg8::EpiResid<false>, pg8::StaticOrder, true, true>(lds, g, S, E);
    }
    TPROBE_END(7);
    xcd_barrier(bar);
    {
        const int gw = bx * NWAVES + wave, NGW = G * NWAVES;
        for (int m = gw * 4; m < M_TOK; m += NGW * 4) rms_rows4_f32(out + (size_t)m * DM, g_final, lane);
    }
}

extern "C" void kernel_launch(void* const* d_in, const int* in_sizes, int n_in, void* d_out, int out_size, void* d_ws, size_t ws_size, hipStream_t stream) {
    static int grid = 0;
    if (grid == 0) {
        if (n_in != 13 || out_size != M_TOK * DM || ws_size < WS_END) { fprintf(stderr, "kernel_launch: unexpected shapes (n_in %d out %d ws %zu)\n", n_in, out_size, ws_size); grid = -1; return; }
        int dev = 0, cus = 0, per_cu = 0;
        hipGetDevice(&dev); hipDeviceGetAttribute(&cus, hipDeviceAttributeMultiprocessorCount, dev);
        hipFuncSetAttribute((const void*)mega_fwd, hipFuncAttributeMaxDynamicSharedMemorySize, LDS_BYTES);
        if (hipOccupancyMaxActiveBlocksPerMultiprocessor(&per_cu, (const void*)mega_fwd, NWAVES * 64, LDS_BYTES) != hipSuccess || per_cu < 1) { fprintf(stderr, "kernel_launch: occupancy query says %d\n", per_cu); per_cu = 1; }
        (void)hipGetLastError();
        grid = cus * 1;
    }
    if (grid < 0) return;
    Args a{};
    for (int i = 0; i < 13; ++i) a.in[i] = (const float*)d_in[i];
    a.out = (float*)d_out; a.ws = (unsigned char*)d_ws;
    void* params[] = {&a};
    hipError_t e = hipLaunchCooperativeKernel((const void*)mega_fwd, dim3(grid), dim3(NWAVES * 64), params, LDS_BYTES, stream);
    if (e != hipSuccess) fprintf(stderr, "cooperative launch failed: %s (grid %d)\n", hipGetErrorString(e), grid);
}
```
